# Optimizing an MI355X kernel written in HIP

```python
import jax, jax.numpy as jnp
from jax import lax
import numpy as np

D_MODEL = 1024
BATCH = 16
SEQ = 4096
DEPTH = 1

D_MIX = D_MODEL
GLA_HEADS = 4
GLA_DK = 64
GLA_DV = 128
GLA_RANK = 16
GLA_GATE_NORM = 16.0
GLA_CHUNK = 64
SB_HEADS = 8
SB_DH = 64
SB_BLOCK = 128
D_FF = 2816
EPS = 1e-6

GLA_QK = GLA_HEADS * GLA_DK
GLA_V = GLA_HEADS * GLA_DV
SB_W = SB_HEADS * SB_DH
PROJ_SIZES = (GLA_QK, GLA_QK, GLA_V, GLA_V, GLA_RANK, SB_W, SB_W, SB_W)
PROJ_SPLITS = tuple(int(s) for s in np.cumsum(PROJ_SIZES)[:-1])
D_IN = int(sum(PROJ_SIZES))

kernel_name = "hymba_style_gla_stickbreaking_macaron"


def rmsnorm(x, g):
    xf = x.astype(jnp.float32)
    y = xf * lax.rsqrt(jnp.mean(xf * xf, axis=-1, keepdims=True) + EPS)
    return (y * g.astype(jnp.float32)).astype(x.dtype)


def swiglu(h, w_gate, w_up, w_down):
    return (jax.nn.silu(h @ w_gate) * (h @ w_up)) @ w_down


def gla_chunked(q, k, v, log_a):
    B, T, H, DK = q.shape
    DV = v.shape[-1]
    C = GLA_CHUNK
    N = T // C

    def chunks(t):
        return t.reshape(B, N, C, H, t.shape[-1]).transpose(0, 3, 1, 2, 4)

    q, k, v, log_a = chunks(q * (GLA_DK ** -0.5)), chunks(k), chunks(v), chunks(log_a)
    b = jnp.cumsum(log_a, axis=3)
    b_last = b[:, :, :, -1:, :]
    q_dec = q * jnp.exp(b)
    k_inv = k * jnp.exp(-b)
    k_end = k * jnp.exp(b_last - b)
    causal = jnp.tril(jnp.ones((C, C), dtype=bool))
    scores = jnp.where(causal, jnp.einsum('bhnid,bhnjd->bhnij', q_dec, k_inv), 0.0)
    o_intra = jnp.einsum('bhnij,bhnjv->bhniv', scores, v)

    def step(state, xs):
        k_n, v_n, decay_n = xs
        new = decay_n[..., None] * state + jnp.einsum('bhcd,bhcv->bhdv', k_n, v_n)
        return new, state

    xs = (jnp.moveaxis(k_end, 2, 0), jnp.moveaxis(v, 2, 0),
          jnp.moveaxis(jnp.exp(b_last[:, :, :, 0, :]), 2, 0))
    _, states = lax.scan(step, jnp.zeros((B, H, DK, DV), jnp.float32), xs)
    states = jnp.moveaxis(states, 0, 2)
    o_inter = jnp.einsum('bhnid,bhndv->bhniv', q_dec, states)
    o = o_intra + o_inter
    return o.transpose(0, 2, 3, 1, 4).reshape(B, T, H, DV)


def stick_breaking(q, k, v):
    B, T, H, D = q.shape
    NB = T // SB_BLOCK
    scale = D ** -0.5
    q = q.transpose(0, 2, 1, 3)
    k = k.transpose(0, 2, 1, 3)
    v = v.transpose(0, 2, 1, 3)
    q_blocks = q.reshape(B, H, NB, SB_BLOCK, D).transpose(2, 0, 1, 3, 4)
    key_pos = jnp.arange(T)

    def block(args):
        qb, i = args
        z = jnp.einsum('bhqd,bhkd->bhqk', qb, k) * scale
        t_pos = i * SB_BLOCK + jnp.arange(SB_BLOCK)
        mask = key_pos[None, :] < t_pos[:, None]
        log_keep = jnp.where(mask, jax.nn.log_sigmoid(-z), 0.0)
        between = lax.cumsum(log_keep, axis=3, reverse=True) - log_keep
        w = jnp.where(mask, jnp.exp(jax.nn.log_sigmoid(z) + between), 0.0)
        return jnp.einsum('bhqk,bhkd->bhqd', w, v)

    out = lax.map(block, (q_blocks, jnp.arange(NB)))
    return out.transpose(1, 0, 3, 2, 4).reshape(B, T, H, D)


def setup_inputs(seed: int = 0) -> dict:
    key = jax.random.key(seed)
    ks = jax.random.split(key, 20)
    f32 = jnp.float32

    def w(k, shape, fan_in):
        return jax.random.normal(k, shape, f32) * (fan_in ** -0.5)

    def gain(k, n):
        return 1.0 + 0.02 * jax.random.normal(k, (DEPTH, n), f32)

    return {
        "x": jax.random.normal(ks[0], (BATCH, SEQ, D_MODEL), f32),
        "ffn1_norm": gain(ks[1], D_MODEL),
        "ffn1_w_gate": w(ks[2], (DEPTH, D_MODEL, D_FF), D_MODEL),
        "ffn1_w_up": w(ks[3], (DEPTH, D_MODEL, D_FF), D_MODEL),
        "ffn1_w_down": w(ks[4], (DEPTH, D_FF, D_MODEL), D_FF),
        "mix_norm": gain(ks[5], D_MODEL),
        "w_in": w(ks[6], (DEPTH, D_MODEL, D_IN), D_MODEL),
        "w_gk_up": w(ks[7], (DEPTH, GLA_RANK, GLA_QK), GLA_RANK),
        "b_gk": 0.1 * jax.random.normal(ks[8], (DEPTH, GLA_QK), f32),
        "gla_out_norm": gain(ks[9], GLA_DV),
        "sb_q_norm": gain(ks[10], SB_DH),
        "sb_k_norm": gain(ks[11], SB_DH),
        "w_out": w(ks[12], (DEPTH, D_MIX, D_MODEL), D_MIX),
        "ffn2_norm": gain(ks[13], D_MODEL),
        "ffn2_w_gate": w(ks[14], (DEPTH, D_MODEL, D_FF), D_MODEL),
        "ffn2_w_up": w(ks[15], (DEPTH, D_MODEL, D_FF), D_MODEL),
        "ffn2_w_down": w(ks[16], (DEPTH, D_FF, D_MODEL), D_FF),
    }


def reference(x, ffn1_norm, ffn1_w_gate, ffn1_w_up, ffn1_w_down, mix_norm, w_in,
              w_gk_up, b_gk, gla_out_norm, sb_q_norm, sb_k_norm, w_out,
              ffn2_norm, ffn2_w_gate, ffn2_w_up, ffn2_w_down):
    B, T, _ = x.shape
    f32 = jnp.float32
    for l in range(DEPTH):
        x = x + 0.5 * swiglu(rmsnorm(x, ffn1_norm[l]), ffn1_w_gate[l], ffn1_w_up[l], ffn1_w_down[l])

        h = rmsnorm(x, mix_norm[l])
        p = h @ w_in[l]
        g_q, g_k, g_v, g_gate, g_lr, s_q, s_k, s_v = jnp.split(p, PROJ_SPLITS, axis=-1)

        log_a = jax.nn.log_sigmoid((g_lr @ w_gk_up[l] + b_gk[l]).astype(f32)) / GLA_GATE_NORM
        o_gla = gla_chunked(g_q.astype(f32).reshape(B, T, GLA_HEADS, GLA_DK),
                            g_k.astype(f32).reshape(B, T, GLA_HEADS, GLA_DK),
                            g_v.astype(f32).reshape(B, T, GLA_HEADS, GLA_DV),
                            log_a.reshape(B, T, GLA_HEADS, GLA_DK))
        o_gla = rmsnorm(o_gla, gla_out_norm[l]) * jax.nn.silu(
            g_gate.astype(f32).reshape(B, T, GLA_HEADS, GLA_DV))
        o_gla = o_gla.reshape(B, T, GLA_V)

        q_sb = rmsnorm(s_q.astype(f32).reshape(B, T, SB_HEADS, SB_DH), sb_q_norm[l])
        k_sb = rmsnorm(s_k.astype(f32).reshape(B, T, SB_HEADS, SB_DH), sb_k_norm[l])
        o_sb = stick_breaking(q_sb, k_sb, s_v.astype(f32).reshape(B, T, SB_HEADS, SB_DH))
        o_sb = o_sb.reshape(B, T, SB_W)

        mixed = jnp.concatenate([o_gla, o_sb], axis=-1).astype(x.dtype)
        x = x + mixed @ w_out[l]

        x = x + 0.5 * swiglu(rmsnorm(x, ffn2_norm[l]), ffn2_w_gate[l], ffn2_w_up[l], ffn2_w_down[l])
    return x
```

```cpp
#include <hip/hip_runtime.h>
#include <cstdio>
#include <cstdint>
#include <cmath>
namespace pg8 {
#define PG8_LAS __attribute__((address_space(3)))
typedef unsigned short bf16_t;
typedef short bf16x8 __attribute__((ext_vector_type(8)));
typedef float f32x4 __attribute__((ext_vector_type(4)));
typedef unsigned u32x4 __attribute__((ext_vector_type(4)));
constexpr int BM = 256, BK = 64, HALF = 128, HTB = HALF * BK * 2  , STAGE_BYTES = 8 * HTB, NXCD = 8, WGM = 8;

__host__ __device__ __forceinline__ int lds_byte(int r, int c) { const int st = (r >> 4) * 2 + (c >> 5), rr = r & 15, cc = c & 31, ob = rr * 64 + cc * 2; return st * 1024 + (ob ^ (((ob >> 9) & 1) << 5)); }
__host__ __device__ __forceinline__ void stage_rc(int b, int& R, int& C) { const int st = b / 1024, sb = b % 1024, swz = sb ^ (((sb >> 9) & 1) << 5); R = (st >> 1) * 16 + swz / 64; C = (st & 1) * 32 + (swz % 64) / 2; }
__host__ __device__ __forceinline__ int perm32(int rho) { const int n = rho >> 4, i = rho & 15; return 8 * (i >> 2) + 4 * n + (i & 3); }

struct Unit { int pm, pn; };
struct Gemm { const bf16_t* A; const bf16_t* Bt; int M, N, K; };

struct StaticOrder {
    int nM, nN, nwg, G, c;
    __host__ __device__ void init(int M, int N, int G_, int c_) { nM = M / BM; nN = N / BM; nwg = nM * nN; G = G_; c = c_; }
    __host__ __device__ bool next(int i, Unit& u) const {
        const long L = (long)i * G + c; if (L >= nwg) return false;
        int wgid = (int)L; { const int q = nwg / NXCD, r = nwg % NXCD, xcd = wgid % NXCD, off = wgid / NXCD; wgid = (xcd < r ? xcd * (q + 1) : r * (q + 1) + (xcd - r) * q) + off; }
        const int nig = WGM * nN, gid = wgid / nig, fm = gid * WGM, gsz = (nM - fm) < WGM ? (nM - fm) : WGM;
        u.pm = fm + ((wgid % nig) % gsz); u.pn = (wgid % nig) / gsz; return true;
    }
    __device__ __forceinline__ void a_ready(const Unit&) const {}
    __device__ __forceinline__ void done(const Unit&) const {}
};

__device__ __forceinline__ unsigned cvt_pk_bf16(float lo, float hi) { unsigned r; asm volatile("v_cvt_pk_bf16_f32 %0, %1, %2" : "=v"(r) : "v"(lo), "v"(hi)); return r; }
typedef float f32x2 __attribute__((ext_vector_type(2)));
constexpr float NORM_EPS = 1e-6f;
constexpr float LOG2E = 1.4426950408889634f;
__device__ __forceinline__ float silu_f(float g) { return g * __builtin_amdgcn_rcpf(1.0f + __builtin_amdgcn_exp2f(-g * LOG2E)); }
__device__ __forceinline__ float row_rs(const float* ss, int row, float inv_n) { return __builtin_amdgcn_rsqf(ss[row] * inv_n + NORM_EPS); }

struct EpiSwiGLU {
    static constexpr bool PERM = true, AFTER_DRAIN = false;
    bf16_t* O; int ldo; const float* ss;
    __device__ __forceinline__ void operator()(const f32x4 (&acc)[2][2][4][2], const Unit& u, int wr, int wc, int fr, int fq) const {
        const int row0 = u.pm * BM + wr * 64 + fr, col0 = u.pn * HALF + wc * 32 + 8 * fq;
#pragma unroll
        for (int ai = 0; ai < 2; ++ai)
#pragma unroll
            for (int m = 0; m < 4; ++m) {
                const int row = row0 + ai * HALF + m * 16;
                const float r = row_rs(ss, row, 1.0f / 1024.0f);
                float a[8];
#pragma unroll
                for (int n = 0; n < 2; ++n)
#pragma unroll
                    for (int i = 0; i < 4; ++i) { const float g = acc[ai][0][m][n][i] * r, up = acc[ai][1][m][n][i] * r; a[4 * n + i] = silu_f(g) * up; }
                u32x4 w; w.x = cvt_pk_bf16(a[0], a[1]); w.y = cvt_pk_bf16(a[2], a[3]); w.z = cvt_pk_bf16(a[4], a[5]); w.w = cvt_pk_bf16(a[6], a[7]);
                *(u32x4*)(O + (size_t)row * ldo + col0) = w;
            }
    }
};

struct EpiRes {
    static constexpr bool PERM = true, AFTER_DRAIN = false;
    const float* base; float* out; float alpha; bf16_t* xb; float* ssq;
    __device__ __forceinline__ void operator()(const f32x4 (&acc)[2][2][4][2], const Unit& u, int wr, int wc, int fr, int fq) const {
        const int row0 = u.pm * BM + wr * 64 + fr, col0 = u.pn * BM + wc * 32 + 8 * fq;
#pragma unroll
        for (int ai = 0; ai < 2; ++ai)
#pragma unroll
            for (int m = 0; m < 4; ++m) {
                const int row = row0 + ai * HALF + m * 16;
                const size_t off = (size_t)row * 1024 + col0;
                float sq = 0.f;
#pragma unroll
                for (int bj = 0; bj < 2; ++bj) {
                    const f32x4 b0 = *(const f32x4*)(base + off + bj * HALF), b1 = *(const f32x4*)(base + off + bj * HALF + 4);
                    const f32x4 o0 = b0 + acc[ai][bj][m][0] * alpha, o1 = b1 + acc[ai][bj][m][1] * alpha;
                    *(f32x4*)(out + off + bj * HALF) = o0; *(f32x4*)(out + off + bj * HALF + 4) = o1;
                    if (xb) { u32x4 w; w.x = cvt_pk_bf16(o0[0], o0[1]); w.y = cvt_pk_bf16(o0[2], o0[3]); w.z = cvt_pk_bf16(o1[0], o1[1]); w.w = cvt_pk_bf16(o1[2], o1[3]);
                        *(u32x4*)(xb + off + bj * HALF) = w; }
                    sq += (o0[0] * o0[0] + o0[1] * o0[1]) + (o0[2] * o0[2] + o0[3] * o0[3]) + (o1[0] * o1[0] + o1[1] * o1[1]) + (o1[2] * o1[2] + o1[3] * o1[3]);
                }
                if (ssq) { sq += __shfl_xor(sq, 16); sq += __shfl_xor(sq, 32); if (fq == 0) atomicAdd(ssq + row, sq); }
                if (m & 1) asm volatile("" ::: "memory");
            }
    }
};

struct EpiProj {
    static constexpr bool PERM = true, AFTER_DRAIN = false;
    bf16_t* P; int ldp; const float* ss; const float* qg; const float* kg; float qscale;
    __device__ __forceinline__ void operator()(const f32x4 (&acc)[2][2][4][2], const Unit& u, int wr, int wc, int fr, int fq) const {
        const int row0 = u.pm * BM + wr * 64 + fr; const int pn = u.pn;
        if (pn >= 6 && pn <= 9) {
            const float* gp = (pn < 8) ? qg : kg; const float gs = (pn < 8) ? qscale : 1.0f;
            float gn[2][8];
#pragma unroll
            for (int bj = 0; bj < 2; ++bj)
#pragma unroll
                for (int j = 0; j < 8; ++j) gn[bj][j] = gp[32 * bj + 8 * fq + j] * gs;
#pragma unroll
            for (int ai = 0; ai < 2; ++ai)
#pragma unroll
                for (int m = 0; m < 4; ++m) {
                    const int row = row0 + ai * HALF + m * 16;
                    const float r = row_rs(ss, row, 1.0f / 1024.0f);
                    float v[2][8]; float sq = 0.f;
#pragma unroll
                    for (int bj = 0; bj < 2; ++bj)
#pragma unroll
                        for (int n = 0; n < 2; ++n)
#pragma unroll
                            for (int i = 0; i < 4; ++i) { const float t = acc[ai][bj][m][n][i] * r; v[bj][4 * n + i] = t; sq += t * t; }
                    sq += __shfl_xor(sq, 16); sq += __shfl_xor(sq, 32);
                    const float rr = __builtin_amdgcn_rsqf(sq * (1.0f / 64.0f) + NORM_EPS);
#pragma unroll
                    for (int bj = 0; bj < 2; ++bj) {
                        u32x4 w; w.x = cvt_pk_bf16(v[bj][0] * rr * gn[bj][0], v[bj][1] * rr * gn[bj][1]); w.y = cvt_pk_bf16(v[bj][2] * rr * gn[bj][2], v[bj][3] * rr * gn[bj][3]);
                        w.z = cvt_pk_bf16(v[bj][4] * rr * gn[bj][4], v[bj][5] * rr * gn[bj][5]); w.w = cvt_pk_bf16(v[bj][6] * rr * gn[bj][6], v[bj][7] * rr * gn[bj][7]);
                        *(u32x4*)(P + (size_t)row * ldp + pn * BM + 64 * wc + 32 * bj + 8 * fq) = w;
                    }
                }
        } else {
            const float sc = (pn == 0) ? 0.125f : 1.0f;
            const bool skip_hi = (pn == 12);
#pragma unroll
            for (int ai = 0; ai < 2; ++ai)
#pragma unroll
                for (int m = 0; m < 4; ++m) {
                    const int row = row0 + ai * HALF + m * 16;
                    const float r = row_rs(ss, row, 1.0f / 1024.0f) * sc;
#pragma unroll
                    for (int bj = 0; bj < 2; ++bj) {
                        const f32x4 v0 = acc[ai][bj][m][0] * r, v1 = acc[ai][bj][m][1] * r;
                        u32x4 w; w.x = cvt_pk_bf16(v0[0], v0[1]); w.y = cvt_pk_bf16(v0[2], v0[3]); w.z = cvt_pk_bf16(v1[0], v1[1]); w.w = cvt_pk_bf16(v1[2], v1[3]);
                        const int c = bj * HALF + wc * 32 + 8 * fq;
                        if (!skip_hi || c < 16) *(u32x4*)(P + (size_t)row * ldp + pn * BM + c) = w;
                    }
                }
        }
    }
};

template <class Epi, class Sched, bool ALIGN_EPI = false, bool SP2 = false>
__device__ __forceinline__ void gemm_phase(PG8_LAS unsigned char* lds, const Gemm g, const Sched& S, const Epi& E) {
    const int tid = threadIdx.x, wid = __builtin_amdgcn_readfirstlane(tid >> 6), lane = tid & 63, wr = wid >> 2, wc = wid & 3, fr = lane & 15, fq = lane >> 4;
    const int K = g.K, nt = K / BK;
    unsigned voffA[2], voffB[2];
#pragma unroll
    for (int i = 0; i < 2; ++i) { int R, C; stage_rc(tid * 16 + i * 8192, R, C); const int Rb = Epi::PERM ? ((R & ~31) + perm32(R & 31)) : R;
        voffA[i] = (unsigned)(R * K + C) * 2u; voffB[i] = (unsigned)(Rb * K + C) * 2u; }
    const size_t kstep = (size_t)(BK * 2);
    const size_t hstep = (size_t)HALF * K * 2;
    const size_t tstep = 2 * hstep;
    const unsigned ldsw = (unsigned)wid * 1024u;
    const int aoff = lds_byte(wr * 64 + fr, fq * 8), boff = lds_byte(wc * 32 + fr, fq * 8);
#define PG8_SA(b, h) (((b) * 2 + (h)) * HTB)
#define PG8_SB(b, h) ((4 + (b) * 2 + (h)) * HTB)
#define PG8_STAGE(bufoff, gbase, voff) do { _Pragma("unroll") for (int _i = 0; _i < 2; ++_i) \
        __builtin_amdgcn_global_load_lds((const unsigned*)((const char*)(gbase) + (voff)[_i]), (PG8_LAS unsigned*)(lds + (bufoff) + ldsw + _i * 8192), 16, 0, 0); } while (0)
#define PG8_LDA(dst, b, h) do { _Pragma("unroll") for (int m = 0; m < 4; ++m) _Pragma("unroll") for (int k = 0; k < 2; ++k) dst[m][k] = *(const PG8_LAS bf16x8*)(lds + PG8_SA(b, h) + aoff + m * 2048 + k * 1024); } while (0)
#define PG8_LDB(dst, b, h) do { _Pragma("unroll") for (int n = 0; n < 2; ++n) _Pragma("unroll") for (int k = 0; k < 2; ++k) dst[n][k] = *(const PG8_LAS bf16x8*)(lds + PG8_SB(b, h) + boff + n * 2048 + k * 1024); } while (0)
#define PG8_MMA(ai, bj, At, Bt) do { __builtin_amdgcn_s_setprio(1); _Pragma("unroll") for (int m = 0; m < 4; ++m) _Pragma("unroll") for (int n = 0; n < 2; ++n) _Pragma("unroll") for (int k = 0; k < 2; ++k) \
        acc[ai][bj][m][n] = __builtin_amdgcn_mfma_f32_16x16x32_bf16(Bt[n][k], At[m][k], acc[ai][bj][m][n], 0, 0, 0); __builtin_amdgcn_s_setprio(0); } while (0)
#define PG8_WAIT_V(n) asm volatile("s_waitcnt vmcnt(" #n ")" ::: "memory")
#define PG8_WAIT_L(n) asm volatile("s_waitcnt lgkmcnt(" #n ")" ::: "memory")
#define PG8_BAR __builtin_amdgcn_s_barrier()
#define PG8_SCHED __builtin_amdgcn_sched_barrier(0)
    Unit cur, nxt; int ui = 0;
    if (!S.next(0, cur)) return;
    f32x4 acc[2][2][4][2];
#pragma unroll
    for (int a = 0; a < 2; ++a)
#pragma unroll
        for (int b = 0; b < 2; ++b)
#pragma unroll
            for (int m = 0; m < 4; ++m)
#pragma unroll
                for (int n = 0; n < 2; ++n) acc[a][b][m][n] = (f32x4){0.f, 0.f, 0.f, 0.f};
    bf16x8 At[4][2], B0[2][2], B1[2][2];
    const char* cA = (const char*)g.A + (size_t)cur.pm * tstep; const char* cB = (const char*)g.Bt + (size_t)cur.pn * tstep;
    S.a_ready(cur);
    if constexpr (SP2) {
        PG8_STAGE(PG8_SB(0, 0), cB, voffB); PG8_STAGE(PG8_SB(0, 1), cB + hstep, voffB); PG8_STAGE(PG8_SA(0, 0), cA, voffA); PG8_STAGE(PG8_SA(0, 1), cA + hstep, voffA);
        if (wr == 1) PG8_BAR;
        PG8_WAIT_V(2); PG8_BAR;
        PG8_STAGE(PG8_SB(1, 0), cB + kstep, voffB); PG8_STAGE(PG8_SA(1, 0), cA + kstep, voffA); PG8_STAGE(PG8_SB(1, 1), cB + hstep + kstep, voffB);
        PG8_WAIT_V(6); PG8_BAR;
    } else {
        PG8_STAGE(PG8_SB(0, 0), cB, voffB); PG8_STAGE(PG8_SA(0, 0), cA, voffA); PG8_STAGE(PG8_SB(0, 1), cB + hstep, voffB); PG8_STAGE(PG8_SA(0, 1), cA + hstep, voffA);
        if (wr == 1) PG8_BAR;
        PG8_WAIT_V(4); PG8_BAR;
        PG8_STAGE(PG8_SB(1, 0), cB + kstep, voffB); PG8_STAGE(PG8_SA(1, 0), cA + kstep, voffA); PG8_STAGE(PG8_SB(1, 1), cB + hstep + kstep, voffB);
        PG8_WAIT_V(6); PG8_BAR;
    }
    for (;;) {
        const bool has_next = S.next(ui + 1, nxt);
        const char* nA = has_next ? (const char*)g.A + (size_t)nxt.pm * tstep : cA; const char* nB = has_next ? (const char*)g.Bt + (size_t)nxt.pn * tstep : cB;
        for (int t = 0; t < nt; t += 2) {
            const bool last = (t == nt - 2);
            const char* a1 = cA + (size_t)(t + 1) * kstep;
            const char* a2 = last ? nA : cA + (size_t)(t + 2) * kstep; const char* b2 = last ? nB : cB + (size_t)(t + 2) * kstep;
            const char* a3 = a2 + kstep; const char* b3 = b2 + kstep;
            if (last && has_next) S.a_ready(nxt);
            if constexpr (SP2) {
            PG8_LDB(B0, 0, 0); PG8_LDB(B1, 0, 1); PG8_SCHED; PG8_LDA(At, 0, 0); PG8_STAGE(PG8_SA(1, 1), a1 + hstep, voffA);
            PG8_WAIT_V(8); PG8_WAIT_L(0); PG8_BAR; PG8_MMA(0, 0, At, B0); PG8_MMA(0, 1, At, B1); PG8_BAR; PG8_SCHED;
            PG8_LDA(At, 0, 1); PG8_STAGE(PG8_SB(0, 0), b2, voffB); PG8_STAGE(PG8_SB(0, 1), b2 + hstep, voffB); PG8_STAGE(PG8_SA(0, 0), a2, voffA);
            PG8_WAIT_V(8); PG8_WAIT_L(0); PG8_BAR; PG8_MMA(1, 0, At, B0); PG8_MMA(1, 1, At, B1); PG8_BAR; PG8_SCHED;
            PG8_LDB(B0, 1, 0); PG8_LDB(B1, 1, 1); PG8_SCHED; PG8_LDA(At, 1, 0); PG8_STAGE(PG8_SA(0, 1), a2 + hstep, voffA);
            PG8_WAIT_V(8); PG8_WAIT_L(0); PG8_BAR; PG8_MMA(0, 0, At, B0); PG8_MMA(0, 1, At, B1); PG8_BAR; PG8_SCHED;
            PG8_LDA(At, 1, 1); PG8_STAGE(PG8_SB(1, 0), b3, voffB); PG8_STAGE(PG8_SB(1, 1), b3 + hstep, voffB); PG8_STAGE(PG8_SA(1, 0), a3, voffA);
            PG8_WAIT_V(8); PG8_WAIT_L(0); PG8_BAR; PG8_MMA(1, 0, At, B0); PG8_MMA(1, 1, At, B1); PG8_BAR; PG8_SCHED;
            } else {
            PG8_LDB(B0, 0, 0); PG8_SCHED; PG8_LDA(At, 0, 0); PG8_STAGE(PG8_SA(1, 1), a1 + hstep, voffA);
            PG8_WAIT_L(8); PG8_BAR; PG8_WAIT_L(0); PG8_MMA(0, 0, At, B0); PG8_BAR; PG8_SCHED;
            PG8_LDB(B1, 0, 1); PG8_STAGE(PG8_SB(0, 0), b2, voffB);
            PG8_BAR; PG8_WAIT_L(0); PG8_MMA(0, 1, At, B1); PG8_BAR;
            PG8_LDA(At, 0, 1); PG8_STAGE(PG8_SA(0, 0), a2, voffA);
            PG8_BAR; PG8_WAIT_L(0); PG8_MMA(1, 0, At, B0); PG8_BAR; PG8_SCHED;
            PG8_STAGE(PG8_SB(0, 1), b2 + hstep, voffB);
            PG8_WAIT_V(6); PG8_BAR; PG8_MMA(1, 1, At, B1); PG8_BAR;
            PG8_LDB(B0, 1, 0); PG8_SCHED; PG8_LDA(At, 1, 0); PG8_STAGE(PG8_SA(0, 1), a2 + hstep, voffA);
            PG8_WAIT_L(8); PG8_BAR; PG8_WAIT_L(0); PG8_MMA(0, 0, At, B0); PG8_BAR; PG8_SCHED;
            PG8_LDB(B1, 1, 1); PG8_STAGE(PG8_SB(1, 0), b3, voffB);
            PG8_BAR; PG8_WAIT_L(0); PG8_MMA(0, 1, At, B1); PG8_BAR;
            PG8_LDA(At, 1, 1); PG8_STAGE(PG8_SA(1, 0), a3, voffA);
            PG8_BAR; PG8_WAIT_L(0); PG8_MMA(1, 0, At, B0); PG8_BAR; PG8_SCHED;
            PG8_STAGE(PG8_SB(1, 1), b3 + hstep, voffB);
            PG8_WAIT_V(6); PG8_BAR; PG8_MMA(1, 1, At, B1); PG8_BAR;
            }
        }
        if constexpr (ALIGN_EPI) { if (wr == 0) PG8_BAR; }
        if constexpr (!Epi::AFTER_DRAIN) { E(acc, cur, wr, wc, fr, fq); S.done(cur); }
        if (!has_next) break;
#pragma unroll
        for (int a = 0; a < 2; ++a)
#pragma unroll
            for (int b = 0; b < 2; ++b)
#pragma unroll
                for (int m = 0; m < 4; ++m)
#pragma unroll
                    for (int n = 0; n < 2; ++n) acc[a][b][m][n] = (f32x4){0.f, 0.f, 0.f, 0.f};
        cur = nxt; cA = nA; cB = nB; ++ui;
        if constexpr (ALIGN_EPI) { if (wr == 1) PG8_BAR; }
    }
    PG8_WAIT_V(0);
    if constexpr (!ALIGN_EPI) { if (wr == 0) PG8_BAR; }
    PG8_BAR;
    if constexpr (Epi::AFTER_DRAIN) { E.fused(acc, cur, wr, wc, fr, fq, lds, wid, lane); S.done(cur); }
#undef PG8_SA
#undef PG8_SB
#undef PG8_STAGE
#undef PG8_LDA
#undef PG8_LDB
#undef PG8_MMA
#undef PG8_WAIT_V
#undef PG8_WAIT_L
#undef PG8_BAR
#undef PG8_SCHED
}
}
#define GAS __attribute__((address_space(1)))
#define LAS __attribute__((address_space(3)))
typedef unsigned short bf16;
typedef unsigned v4u __attribute__((ext_vector_type(4)));
typedef float f32x4 __attribute__((ext_vector_type(4)));
typedef short bf16x8 __attribute__((ext_vector_type(8)));
typedef GAS unsigned gu32;
typedef GAS unsigned long long gu64;
#define RLX_AGENT __ATOMIC_RELAXED, __HIP_MEMORY_SCOPE_AGENT
#define LDS_WAIT() asm volatile("s_waitcnt lgkmcnt(0)" ::: "memory")
#define VM_WAIT() asm volatile("s_waitcnt vmcnt(0)" ::: "memory")
__device__ __forceinline__ unsigned long long rt() { return __builtin_amdgcn_s_memrealtime(); }
__device__ __forceinline__ unsigned f2bf(float f) { unsigned u = __builtin_bit_cast(unsigned, f); return (u + 0x7fffu + ((u >> 16) & 1u)) >> 16; }
__device__ __forceinline__ unsigned pk2(float lo, float hi) { return f2bf(lo) | (f2bf(hi) << 16); }

#define XB_TMO      128
#define XB_XCNT(j)  (256  + 64 * (j))
#define XB_XSUB(j)  (1280 + 64 * (j))
#define XB_XGEN(j)  (2304 + 64 * (j))
#define XB_TOP      3328
#define XB_TOPGEN   3392
#define XCD_BAR_WORDS 3456
#define XB_SPIN_CAP (1u << 18)

__device__ __forceinline__ unsigned xb_ld(unsigned* p)              { return __hip_atomic_load(p, __ATOMIC_RELAXED, __HIP_MEMORY_SCOPE_AGENT); }
__device__ __forceinline__ unsigned xb_add(unsigned* p, unsigned v) { return __hip_atomic_fetch_add(p, v, __ATOMIC_RELAXED, __HIP_MEMORY_SCOPE_AGENT); }
__device__ __forceinline__ unsigned xb_xcc_id() { return (unsigned)__builtin_amdgcn_s_getreg((3 << 11) | 20) & 0xFu; }
#define XB_SPIN(cond, bar) do { unsigned _sp = 0; while (cond) { __builtin_amdgcn_s_sleep(1); \
    if ((++_sp & 255u) == 0u) { if (xb_ld(&(bar)[XB_TMO])) break; if (_sp > XB_SPIN_CAP) { atomicAdd(&(bar)[XB_TMO], 1u); break; } } } } while (0)

struct XcdBarrier {
    unsigned* bar; unsigned x;
    volatile LAS unsigned* st;
};

__device__ __forceinline__ XcdBarrier xcd_barrier_post(unsigned* bar, volatile LAS unsigned* st) {
    XcdBarrier b; b.bar = bar; b.x = xb_xcc_id(); b.st = st;
    if (threadIdx.x == 0) (void)xb_add(&bar[XB_XCNT(b.x)], 1u);
    return b;
}
__device__ __forceinline__ void xcd_barrier_complete(unsigned* bar, unsigned x, unsigned& nloc, unsigned& nx) {
    const unsigned G = gridDim.x * gridDim.y * gridDim.z;
    unsigned sum, cnt, mine, sp = 0u;
    for (;;) {
        sum = 0u; cnt = 0u; mine = 0u;
#pragma unroll
        for (unsigned j = 0; j < 16; ++j) { const unsigned c = xb_ld(&bar[XB_XCNT(j)]); sum += c; cnt += (c > 0u) ? 1u : 0u; mine = (j == x) ? c : mine; }
        if (sum == G) break;
        __builtin_amdgcn_s_sleep(1);
        if ((++sp & 255u) == 0u) { if (xb_ld(&bar[XB_TMO])) break; if (sp > XB_SPIN_CAP) { atomicAdd(&bar[XB_TMO], 1u); break; } }
    }
    nloc = mine > 0u ? mine : 1u; nx = cnt > 0u ? cnt : 1u;
}

__device__ __forceinline__ void xcd_barrier(const XcdBarrier& b) {
    asm volatile("s_waitcnt vmcnt(0)" ::: "memory");
    __syncthreads();
    if (threadIdx.x == 0) {
        unsigned* bar = b.bar;
        __builtin_amdgcn_s_waitcnt(0);
        unsigned nloc = b.st[0], nx = b.st[1];
        if (nloc == 0u) { xcd_barrier_complete(bar, b.x, nloc, nx); b.st[0] = nloc; b.st[1] = nx; }
        const unsigned old = xb_add(&bar[XB_XSUB(b.x)], 1u);
        const unsigned gen = old / nloc;
        if (old + 1u == (gen + 1u) * nloc) {
            __builtin_amdgcn_fence(__ATOMIC_RELEASE, "agent");
            asm volatile("s_waitcnt vmcnt(0)" ::: "memory");
            const unsigned og = xb_add(&bar[XB_TOP], 1u);
            const unsigned tg = og / nx;
            if (og + 1u == (tg + 1u) * nx) xb_add(&bar[XB_TOPGEN], 1u);
            else XB_SPIN(xb_ld(&bar[XB_TOPGEN]) == tg, bar);
            __builtin_amdgcn_fence(__ATOMIC_ACQUIRE, "agent");
            xb_add(&bar[XB_XGEN(b.x)], 1u);
            asm volatile("s_waitcnt vmcnt(0)" ::: "memory");
        } else {
            XB_SPIN(xb_ld(&bar[XB_XGEN(b.x)]) == gen, bar);
            __builtin_amdgcn_fence(__ATOMIC_ACQUIRE, "agent");
            asm volatile("s_waitcnt vmcnt(0)" ::: "memory");
        }
    }
    __syncthreads();
}

constexpr int NWAVES = 8;
constexpr int BATCH = 16, SEQ = 4096, DM = 1024, MROWS = BATCH * SEQ, DFF = 2816;
constexpr int GLA_H = 4, GLA_DK = 64, GLA_DV = 128, GLA_RANK = 16, SB_H = 8, SB_D = 64;
constexpr int NPROJ = 3328;
constexpr int PC_GQ = 0, PC_GK = 256, PC_GV = 512, PC_GG = 1024, PC_SQ = 1536, PC_SK = 2048, PC_SV = 2560, PC_LR = 3072;
constexpr int SRC_GQ = 0, SRC_GK = 256, SRC_GV = 512, SRC_GG = 1024, SRC_LR = 1536, SRC_SQ = 1552, SRC_SK = 2064, SRC_SV = 2576, D_IN = 3088;
constexpr float EPS = 1e-6f;
constexpr float SBQ_SCALE = 0.125f;

constexpr size_t MiB = 1u << 20;
constexpr size_t WS_CTL = 0, CTL_ZERO_BYTES = 2 * MiB;
constexpr size_t WS_SS1 = 1 * MiB, WS_SS2 = 1 * MiB + 256 * 1024, WS_SS0 = 1 * MiB + 512 * 1024;
constexpr size_t WS_W1 = 2 * MiB;
constexpr size_t WS_WD1 = WS_W1 + (size_t)2 * DFF * DM * 2;
constexpr size_t WS_WIN = WS_WD1 + (size_t)DM * DFF * 2;
constexpr size_t WS_WOUT = WS_WIN + (size_t)NPROJ * DM * 2;
constexpr size_t WS_W2 = WS_WOUT + (size_t)DM * DM * 2;
constexpr size_t WS_WD2 = WS_W2 + (size_t)2 * DFF * DM * 2;
constexpr size_t WS_WEND = WS_WD2 + (size_t)DM * DFF * 2;
static_assert(WS_WEND <= 64 * MiB, "weights");
constexpr size_t WS_XB = 64 * MiB;
constexpr size_t WS_MIX = 192 * MiB;
constexpr size_t WS_BIG = 320 * MiB;
constexpr size_t WS_END = WS_BIG + (size_t)MROWS * NPROJ * 2;
constexpr int CW_BAR = 4096;
constexpr int CW_WORK = 1024;

constexpr int RING_OFF = 0, RING_BYTES = 131072;
constexpr int LDSCTL_OFF = RING_BYTES, MISC_OFF = LDSCTL_OFF + 320;
constexpr int LDS_BYTES = 147456;


struct Frame {
    LAS unsigned char* lds;
    volatile LAS unsigned* MISC;
    gu32* ctl;
    int tid, lane, wave;
    int vcu, G;
};

__device__ __forceinline__ float wave_sum(float v) {
#pragma unroll
    for (int o = 1; o < 64; o <<= 1) v += __shfl_xor(v, o);
    return v;
}
__device__ __forceinline__ float bf2f(unsigned short b) { return __builtin_bit_cast(float, (unsigned)b << 16); }
__device__ __forceinline__ float bflo(unsigned w) { return __builtin_bit_cast(float, w << 16); }
__device__ __forceinline__ float bfhi(unsigned w) { return __builtin_bit_cast(float, w & 0xffff0000u); }

__device__ __forceinline__ void tr_item(const float* W, int Nsrc, int sc, int nv, const float* gain, bf16* WT, int K, int drow0, int k0, LAS float* scr, int lane) {
#pragma unroll 8
    for (int i = 0; i < 32; ++i) { const int kk = 2 * i + (lane >> 5), n = lane & 31;
        float v = 0.f; if (n < nv) { v = W[(size_t)(k0 + kk) * Nsrc + sc + n]; if (gain) v *= gain[k0 + kk]; }
        scr[kk * 33 + n] = v; }
    LDS_WAIT(); asm volatile("" ::: "memory");
    const int c = lane & 7;
#pragma unroll
    for (int j = 0; j < 4; ++j) { const int n = (lane >> 3) + 8 * j; const LAS float* s = scr + (8 * c) * 33 + n;
        v4u o; o.x = pk2(s[0 * 33], s[1 * 33]); o.y = pk2(s[2 * 33], s[3 * 33]); o.z = pk2(s[4 * 33], s[5 * 33]); o.w = pk2(s[6 * 33], s[7 * 33]);
        *(GAS v4u*)(WT + (size_t)(drow0 + n) * K + k0 + 8 * c) = o; }
    LDS_WAIT(); asm volatile("" ::: "memory");
}
__device__ __forceinline__ void win_map(int db, int& sc, int& nv) {
    const int tile = db >> 3, r = db & 7, bj = r >> 2, wc = r & 3; nv = 32;
    if (tile < 6) sc = 32 * db;
    else if (tile < 8) sc = SRC_SQ + 256 * (tile - 6) + 64 * wc + 32 * bj;
    else if (tile < 10) sc = SRC_SK + 256 * (tile - 8) + 64 * wc + 32 * bj;
    else if (tile < 12) sc = SRC_SV + 32 * (db - 80);
    else if (db == 96) { sc = SRC_LR; nv = 16; }
    else { sc = 0; nv = 0; }
}
__device__ __forceinline__ void p0_prologue(Frame& F, const float* const* in, unsigned char* ws) {
    LAS float* scr = (LAS float*)(F.lds + RING_OFF + F.wave * 16384);
    const int gw = F.vcu * NWAVES + F.wave, NGW = F.G * NWAVES;
    constexpr int I_W = 176 * 16, I_D = 32 * 44, I_IN = 104 * 16, I_O = 32 * 16;
    constexpr int NITEMS = 2 * I_W + 2 * I_D + I_IN + I_O;
    for (int it = gw; it < NITEMS; it += NGW) {
        int r = it;
        if (r < 2 * I_W) { const int second = r >= I_W; if (second) r -= I_W;
            const int kb = r / 176, db = r % 176, tile = db >> 3, q = db & 7, bj = q >> 2, sub = q & 3;
            const float* W = in[second ? (bj ? 15 : 14) : (bj ? 3 : 2)];
            tr_item(W, DFF, 128 * tile + 32 * sub, 32, in[second ? 13 : 1], (bf16*)(ws + (second ? WS_W2 : WS_W1)), DM, 32 * db, 64 * kb, scr, F.lane); continue; }
        r -= 2 * I_W;
        if (r < 2 * I_D) { const int second = r >= I_D; if (second) r -= I_D;
            const int kb = r / 32, db = r % 32;
            tr_item(in[second ? 16 : 4], DM, 32 * db, 32, nullptr, (bf16*)(ws + (second ? WS_WD2 : WS_WD1)), DFF, 32 * db, 64 * kb, scr, F.lane); continue; }
        r -= 2 * I_D;
        if (r < I_IN) { const int kb = r / 104, db = r % 104; int sc, nv; win_map(db, sc, nv);
            tr_item(in[6], D_IN, sc, nv, in[5], (bf16*)(ws + WS_WIN), DM, 32 * db, 64 * kb, scr, F.lane); continue; }
        r -= I_IN;
        { const int kb = r / 32, db = r % 32;
            tr_item(in[12], DM, 32 * db, 32, nullptr, (bf16*)(ws + WS_WOUT), DM, 32 * db, 64 * kb, scr, F.lane); }
    }
    const float* x = in[0]; bf16* xb = (bf16*)(ws + WS_XB); float* ss0 = (float*)(ws + WS_SS0);
    for (int m = gw; m < MROWS; m += NGW) {
        const GAS f32x4* xr = (const GAS f32x4*)(x + (size_t)m * DM) + F.lane;
        f32x4 v[4]; float s = 0.f;
#pragma unroll
        for (int j = 0; j < 4; ++j) { v[j] = xr[64 * j]; s += (v[j].x * v[j].x + v[j].y * v[j].y) + (v[j].z * v[j].z + v[j].w * v[j].w); }
        s = wave_sum(s);
        GAS unsigned long long* o8 = (GAS unsigned long long*)(xb + (size_t)m * DM) + F.lane;
#pragma unroll
        for (int j = 0; j < 4; ++j) o8[64 * j] = (unsigned long long)pk2(v[j].x, v[j].y) | ((unsigned long long)pk2(v[j].z, v[j].w) << 32);
        if (F.lane == 0) ss0[m] = s;
    }
}

__device__ __forceinline__ float logsig_f(float x) { return fminf(x, 0.f) - log1pf(expf(-fabsf(x))); }

__device__ __forceinline__ void gla_naive_unit(Frame& F, const float* const* in, unsigned char* ws, int bh) {
    const int b = bh >> 2, h = bh & 3, tid = F.tid;
    const bf16* P = (const bf16*)(ws + WS_BIG); bf16* MIX = (bf16*)(ws + WS_MIX);
    LAS float* QS = (LAS float*)(F.lds);
    LAS float* KS = QS + 4096;
    LAS float* AS = KS + 4096;
    LAS float* VS = AS + 4096;
    LAS float* OS = VS + 8192;
    LAS float* LR = OS + 8192;
    LAS float* WU = LR + 1024;
    LAS float* BG = WU + 1024;
    const float* wup = in[7]; const float* bgk = in[8]; const float* gon = in[9];
    for (int i = tid; i < 1024; i += 512) { const int r = i >> 6, d = i & 63; WU[i] = wup[r * 256 + h * 64 + d]; }
    if (tid < 64) BG[tid] = bgk[h * 64 + tid];
    const int dv = tid >> 2, dkq = tid & 3;
    float S[16];
#pragma unroll
    for (int i = 0; i < 16; ++i) S[i] = 0.f;
    const int tok = tid >> 3, sub = tid & 7;
    for (int n = 0; n < SEQ / 64; ++n) {
        const size_t row0 = (size_t)b * SEQ + n * 64;
        const bf16* prow = P + (row0 + tok) * NPROJ;
        { const v4u q = *(const GAS v4u*)(prow + PC_GQ + h * 64 + sub * 8), k = *(const GAS v4u*)(prow + PC_GK + h * 64 + sub * 8);
          LAS float* qd = QS + tok * 64 + sub * 8; LAS float* kd = KS + tok * 64 + sub * 8;
          qd[0] = bflo(q.x); qd[1] = bfhi(q.x); qd[2] = bflo(q.y); qd[3] = bfhi(q.y); qd[4] = bflo(q.z); qd[5] = bfhi(q.z); qd[6] = bflo(q.w); qd[7] = bfhi(q.w);
          kd[0] = bflo(k.x); kd[1] = bfhi(k.x); kd[2] = bflo(k.y); kd[3] = bfhi(k.y); kd[4] = bflo(k.z); kd[5] = bfhi(k.z); kd[6] = bflo(k.w); kd[7] = bfhi(k.w);
#pragma unroll
          for (int j = 0; j < 2; ++j) { const v4u v = *(const GAS v4u*)(prow + PC_GV + h * 128 + sub * 16 + j * 8); LAS float* vd = VS + tok * 128 + sub * 16 + j * 8;
              vd[0] = bflo(v.x); vd[1] = bfhi(v.x); vd[2] = bflo(v.y); vd[3] = bfhi(v.y); vd[4] = bflo(v.z); vd[5] = bfhi(v.z); vd[6] = bflo(v.w); vd[7] = bfhi(v.w); }
          if (sub < 2) { const v4u l = *(const GAS v4u*)(prow + PC_LR + sub * 8); LAS float* ld = LR + tok * 16 + sub * 8;
              ld[0] = bflo(l.x); ld[1] = bfhi(l.x); ld[2] = bflo(l.y); ld[3] = bfhi(l.y); ld[4] = bflo(l.z); ld[5] = bfhi(l.z); ld[6] = bflo(l.w); ld[7] = bfhi(l.w); } }
        __syncthreads();
#pragma unroll
        for (int j = 0; j < 8; ++j) { const int dk = sub * 8 + j; float a = BG[dk];
#pragma unroll
            for (int r = 0; r < 16; ++r) a += LR[tok * 16 + r] * WU[r * 64 + dk];
            AS[tok * 64 + dk] = expf(logsig_f(a) * (1.0f / 16.0f)); }
        __syncthreads();
        for (int t = 0; t < 64; ++t) {
            const float v = VS[t * 128 + dv]; float o = 0.f;
#pragma unroll
            for (int i = 0; i < 16; ++i) { const int dk = dkq * 16 + i; S[i] = AS[t * 64 + dk] * S[i] + KS[t * 64 + dk] * v; o += QS[t * 64 + dk] * S[i]; }
            o += __shfl_xor(o, 1); o += __shfl_xor(o, 2);
            if (dkq == 0) OS[t * 128 + dv] = o;
        }
        __syncthreads();
        { float o[16]; float sq = 0.f;
#pragma unroll
          for (int j = 0; j < 16; ++j) { o[j] = OS[tok * 128 + sub * 16 + j]; sq += o[j] * o[j]; }
          sq += __shfl_xor(sq, 1); sq += __shfl_xor(sq, 2); sq += __shfl_xor(sq, 4);
          const float rr = __builtin_amdgcn_rsqf(sq * (1.0f / 128.0f) + EPS);
          unsigned w[8];
#pragma unroll
          for (int j = 0; j < 2; ++j) { const v4u g = *(const GAS v4u*)(prow + PC_GG + h * 128 + sub * 16 + j * 8);
              const float gv[8] = {bflo(g.x), bfhi(g.x), bflo(g.y), bfhi(g.y), bflo(g.z), bfhi(g.z), bflo(g.w), bfhi(g.w)};
              float r8[8];
#pragma unroll
              for (int i = 0; i < 8; ++i) { const float gt = gv[i]; r8[i] = o[j * 8 + i] * rr * gon[sub * 16 + j * 8 + i] * (gt / (1.0f + expf(-gt))); }
              w[j * 4 + 0] = pk2(r8[0], r8[1]); w[j * 4 + 1] = pk2(r8[2], r8[3]); w[j * 4 + 2] = pk2(r8[4], r8[5]); w[j * 4 + 3] = pk2(r8[6], r8[7]); }
          bf16* orow = MIX + (row0 + tok) * DM + h * 128 + sub * 16;
          *(GAS v4u*)(orow) = (v4u){w[0], w[1], w[2], w[3]}; *(GAS v4u*)(orow + 8) = (v4u){w[4], w[5], w[6], w[7]}; }
        __syncthreads();
    }
}

__device__ __forceinline__ void sb_naive_unit(Frame& F, unsigned char* ws, int bh, int qc) {
    const int b = bh >> 3, h = bh & 7;
    const bf16* P = (const bf16*)(ws + WS_BIG); bf16* MIX = (bf16*)(ws + WS_MIX);
    const int t = qc * 512 + F.tid;
    const bf16* qrow = P + ((size_t)b * SEQ + t) * NPROJ + PC_SQ + h * 64;
    float q[64], o[64];
#pragma unroll
    for (int c = 0; c < 8; ++c) { const v4u w = *(const GAS v4u*)(qrow + c * 8);
        q[c * 8 + 0] = bflo(w.x); q[c * 8 + 1] = bfhi(w.x); q[c * 8 + 2] = bflo(w.y); q[c * 8 + 3] = bfhi(w.y); q[c * 8 + 4] = bflo(w.z); q[c * 8 + 5] = bfhi(w.z); q[c * 8 + 6] = bflo(w.w); q[c * 8 + 7] = bfhi(w.w); }
#pragma unroll
    for (int d = 0; d < 64; ++d) o[d] = 0.f;
    float R = 0.f;
    const int s_hi = qc * 512 + F.wave * 64 + 62;
    const bf16* kbase = P + (size_t)b * SEQ * NPROJ + PC_SK + h * 64;
    const bf16* vbase = P + (size_t)b * SEQ * NPROJ + PC_SV + h * 64;
    for (int s = s_hi; s >= 0; --s) {
        const unsigned* kr = (const unsigned*)(kbase + (size_t)s * NPROJ);
        const unsigned* vr = (const unsigned*)(vbase + (size_t)s * NPROJ);
        if (s < t) {
            float z = 0.f;
#pragma unroll
            for (int c = 0; c < 32; ++c) { const unsigned w = kr[c]; z += q[2 * c] * bflo(w) + q[2 * c + 1] * bfhi(w); }
            const float e = log1pf(expf(-fabsf(z)));
            const float ls = fminf(z, 0.f) - e, lk = fminf(-z, 0.f) - e;
            const float wgt = expf(ls + R); R += lk;
#pragma unroll
            for (int c = 0; c < 32; ++c) { const unsigned w = vr[c]; o[2 * c] += wgt * bflo(w); o[2 * c + 1] += wgt * bfhi(w); }
        }
    }
    bf16* orow = MIX + ((size_t)b * SEQ + t) * DM + 512 + h * 64;
#pragma unroll
    for (int c = 0; c < 8; ++c) *(GAS v4u*)(orow + c * 8) = (v4u){pk2(o[c * 8], o[c * 8 + 1]), pk2(o[c * 8 + 2], o[c * 8 + 3]), pk2(o[c * 8 + 4], o[c * 8 + 5]), pk2(o[c * 8 + 6], o[c * 8 + 7])};
}

__device__ __forceinline__ void p4_mix_naive(Frame& F, const float* const* in, unsigned char* ws) {
    unsigned* ctr = (unsigned*)(F.ctl + CW_WORK);
    for (;;) {
        if (F.tid == 0) F.MISC[0] = atomicAdd(ctr, 1u);
        __syncthreads();
        const unsigned u = F.MISC[0];
        __syncthreads();
        if (u >= 64u + 1024u) break;
        if (u < 64u) gla_naive_unit(F, in, ws, (int)u);
        else { const int a = (int)u - 64; sb_naive_unit(F, ws, a & 127, 7 - (a >> 7)); }
    }
}

constexpr int N_PHASES = 8;
#ifndef MK_N_LAUNCHES
#define MK_N_LAUNCHES 8
#endif
struct Args { const float* in[17]; float* out; unsigned char* ws; int ph_lo, ph_hi; };
__global__ void __launch_bounds__(NWAVES * 64, 2) mk_fwd(Args args) {
    extern __shared__ __attribute__((aligned(16))) unsigned char lds[];
    Frame F;
    F.lds = (LAS unsigned char*)lds;
    F.MISC = (volatile LAS unsigned*)(F.lds + MISC_OFF);
    F.tid = threadIdx.x; F.lane = F.tid & 63; F.wave = __builtin_amdgcn_readfirstlane(F.tid >> 6);
    F.G = gridDim.x; { const int bx = blockIdx.x; F.vcu = (F.G % 8 == 0) ? (bx % 8) * (F.G / 8) + bx / 8 : bx; }
    unsigned char* ws = args.ws;
    F.ctl = (gu32*)(ws + WS_CTL);
    for (int u = F.tid; u < (LDS_BYTES - LDSCTL_OFF) / 4; u += NWAVES * 64) ((LAS unsigned*)(F.lds + LDSCTL_OFF))[u] = 0u;
    __syncthreads();
    XcdBarrier bar; bar.bar = (unsigned*)(F.ctl + CW_BAR); bar.x = 0; bar.st = nullptr;
    if (MK_N_LAUNCHES != N_PHASES) bar = xcd_barrier_post((unsigned*)(F.ctl + CW_BAR), F.MISC + 8);
    const int lo = args.ph_lo, hi = args.ph_hi;
#define IN(k) (lo <= (k) && (k) < hi)
#define BOTH(k) (IN(k) && IN((k) + 1))
#define GRID_BAR() xcd_barrier(bar)
    bf16* XB = (bf16*)(ws + WS_XB); bf16* MIX = (bf16*)(ws + WS_MIX); bf16* BIG = (bf16*)(ws + WS_BIG);
    float* SS0 = (float*)(ws + WS_SS0); float* SS1 = (float*)(ws + WS_SS1); float* SS2 = (float*)(ws + WS_SS2);
    const float* x = args.in[0]; float* out = args.out;

    if (IN(0)) { p0_prologue(F, args.in, ws); if (BOTH(0)) GRID_BAR(); }
    if (IN(1)) {
        pg8::Gemm g{XB, (const bf16*)(ws + WS_W1), MROWS, 2 * DFF, DM}; pg8::StaticOrder S; S.init(MROWS, 2 * DFF, F.G, (int)blockIdx.x);
        pg8::EpiSwiGLU E{BIG, DFF, SS0};
        pg8::gemm_phase<pg8::EpiSwiGLU, pg8::StaticOrder, true, true>(F.lds + RING_OFF, g, S, E);
        if (BOTH(1)) GRID_BAR();
    }
    if (IN(2)) {
        pg8::Gemm g{BIG, (const bf16*)(ws + WS_WD1), MROWS, DM, DFF}; pg8::StaticOrder S; S.init(MROWS, DM, F.G, (int)blockIdx.x);
        pg8::EpiRes E{x, out, 0.5f, XB, SS1};
        pg8::gemm_phase<pg8::EpiRes, pg8::StaticOrder, true, true>(F.lds + RING_OFF, g, S, E);
        if (BOTH(2)) GRID_BAR();
    }
    if (IN(3)) {
        pg8::Gemm g{XB, (const bf16*)(ws + WS_WIN), MROWS, NPROJ, DM}; pg8::StaticOrder S; S.init(MROWS, NPROJ, F.G, (int)blockIdx.x);
        pg8::EpiProj E{BIG, NPROJ, SS1, args.in[10], args.in[11], SBQ_SCALE};
        pg8::gemm_phase<pg8::EpiProj, pg8::StaticOrder, true, true>(F.lds + RING_OFF, g, S, E);
        if (BOTH(3)) GRID_BAR();
    }
    if (IN(4)) { p4_mix_naive(F, args.in, ws); if (BOTH(4)) GRID_BAR(); }
    if (IN(5)) {
        pg8::Gemm g{MIX, (const bf16*)(ws + WS_WOUT), MROWS, DM, DM}; pg8::StaticOrder S; S.init(MROWS, DM, F.G, (int)blockIdx.x);
        pg8::EpiRes E{out, out, 1.0f, XB, SS2};
        pg8::gemm_phase<pg8::EpiRes, pg8::StaticOrder, true, true>(F.lds + RING_OFF, g, S, E);
        if (BOTH(5)) GRID_BAR();
    }
    if (IN(6)) {
        pg8::Gemm g{XB, (const bf16*)(ws + WS_W2), MROWS, 2 * DFF, DM}; pg8::StaticOrder S; S.init(MROWS, 2 * DFF, F.G, (int)blockIdx.x);
        pg8::EpiSwiGLU E{BIG, DFF, SS2};
        pg8::gemm_phase<pg8::EpiSwiGLU, pg8::StaticOrder, true, true>(F.lds + RING_OFF, g, S, E);
        if (BOTH(6)) GRID_BAR();
    }
    if (IN(7)) {
        pg8::Gemm g{BIG, (const bf16*)(ws + WS_WD2), MROWS, DM, DFF}; pg8::StaticOrder S; S.init(MROWS, DM, F.G, (int)blockIdx.x);
        pg8::EpiRes E{out, out, 0.5f, nullptr, nullptr};
        pg8::gemm_phase<pg8::EpiRes, pg8::StaticOrder, true, true>(F.lds + RING_OFF, g, S, E);
    }
#undef IN
#undef BOTH
#undef GRID_BAR
}

extern "C" void kernel_launch(void* const* d_in, const int* in_sizes, int n_in, void* d_out, int out_size, void* d_ws, size_t ws_size, hipStream_t stream) {
    static int grid = 0;
    if (grid == 0) {
        if (n_in != 17 || in_sizes[0] != MROWS * DM || out_size != MROWS * DM || ws_size < WS_END) {
            fprintf(stderr, "kernel_launch: unexpected shapes: n_in %d in0 %d out %d ws %zu (need %zu)\n", n_in, n_in > 0 ? in_sizes[0] : -1, out_size, ws_size, (size_t)WS_END); grid = -1; return; }
        int dev = 0, cus = 0, per_cu = 0;
        if (hipGetDevice(&dev) != hipSuccess || hipDeviceGetAttribute(&cus, hipDeviceAttributeMultiprocessorCount, dev) != hipSuccess) { grid = -1; return; }
        if (hipFuncSetAttribute((const void*)mk_fwd, hipFuncAttributeMaxDynamicSharedMemorySize, LDS_BYTES) != hipSuccess) { fprintf(stderr, "kernel_launch: hipFuncSetAttribute failed\n"); grid = -1; return; }
        if (hipOccupancyMaxActiveBlocksPerMultiprocessor(&per_cu, (const void*)mk_fwd, NWAVES * 64, LDS_BYTES) != hipSuccess || per_cu < 1)
            fprintf(stderr, "kernel_launch: occupancy query reports %d workgroups per CU\n", per_cu);
        (void)hipGetLastError();
        grid = cus;
    }
    if (grid < 0) return;
    if (hipMemsetAsync((char*)d_ws + WS_CTL, 0, CTL_ZERO_BYTES, stream) != hipSuccess) { fprintf(stderr, "kernel_launch: memset failed\n"); return; }
    Args a{};
    for (int i = 0; i < 17; ++i) a.in[i] = (const float*)d_in[i];
    a.out = (float*)d_out; a.ws = (unsigned char*)d_ws;
    for (int li = 0; li < MK_N_LAUNCHES; ++li) {
        if (MK_N_LAUNCHES == N_PHASES) { a.ph_lo = li; a.ph_hi = li + 1; } else { a.ph_lo = 0; a.ph_hi = N_PHASES; }
        hipLaunchKernelGGL(mk_fwd, dim3(grid), dim3(NWAVES * 64), LDS_BYTES, stream, a);
        const hipError_t le = hipPeekAtLastError();
        if (le != hipSuccess) { fprintf(stderr, "kernel_launch: launch %d failed: %s\n", li, hipGetErrorName(le)); break; }
    }
}
```

```cpp
#include <hip/hip_runtime.h>
#include <cstdio>
#include <cstdint>
#include <cmath>
#include <type_traits>
namespace pg8 {
#define PG8_LAS __attribute__((address_space(3)))
typedef unsigned short bf16_t;
typedef short bf16x8 __attribute__((ext_vector_type(8)));
typedef float f32x4 __attribute__((ext_vector_type(4)));
typedef unsigned u32x4 __attribute__((ext_vector_type(4)));
constexpr int BM = 256, BK = 64, HALF = 128, HTB = HALF * BK * 2  , STAGE_BYTES = 8 * HTB, NXCD = 8, WGM = 8;

__host__ __device__ __forceinline__ int lds_byte(int r, int c) { const int st = (r >> 4) * 2 + (c >> 5), rr = r & 15, cc = c & 31, ob = rr * 64 + cc * 2; return st * 1024 + (ob ^ (((ob >> 9) & 1) << 5)); }
__host__ __device__ __forceinline__ void stage_rc(int b, int& R, int& C) { const int st = b / 1024, sb = b % 1024, swz = sb ^ (((sb >> 9) & 1) << 5); R = (st >> 1) * 16 + swz / 64; C = (st & 1) * 32 + (swz % 64) / 2; }
__host__ __device__ __forceinline__ int perm32(int rho) { const int n = rho >> 4, i = rho & 15; return 8 * (i >> 2) + 4 * n + (i & 3); }

struct Unit { int pm, pn; };
struct Gemm { const bf16_t* A; const bf16_t* Bt; int M, N, K; };

struct StaticOrder {
    int nM, nN, nwg, G, c;
    __host__ __device__ void init(int M, int N, int G_, int c_) { nM = M / BM; nN = N / BM; nwg = nM * nN; G = G_; c = c_; }
    __host__ __device__ bool next(int i, Unit& u) const {
        const long L = (long)i * G + c; if (L >= nwg) return false;
        int wgid = (int)L; { const int q = nwg / NXCD, r = nwg % NXCD, xcd = wgid % NXCD, off = wgid / NXCD; wgid = (xcd < r ? xcd * (q + 1) : r * (q + 1) + (xcd - r) * q) + off; }
        const int nig = WGM * nN, gid = wgid / nig, fm = gid * WGM, gsz = (nM - fm) < WGM ? (nM - fm) : WGM;
        u.pm = fm + ((wgid % nig) % gsz); u.pn = (wgid % nig) / gsz; return true;
    }
    __device__ __forceinline__ void a_ready(const Unit&) const {}
    __device__ __forceinline__ void done(const Unit&) const {}
};

__device__ __forceinline__ unsigned cvt_pk_bf16(float lo, float hi) { unsigned r; asm volatile("v_cvt_pk_bf16_f32 %0, %1, %2" : "=v"(r) : "v"(lo), "v"(hi)); return r; }
typedef float f32x2 __attribute__((ext_vector_type(2)));
constexpr float NORM_EPS = 1e-6f;
constexpr float LOG2E = 1.4426950408889634f;
__device__ __forceinline__ float silu_f(float g) { return g * __builtin_amdgcn_rcpf(1.0f + __builtin_amdgcn_exp2f(-g * LOG2E)); }
__device__ __forceinline__ float row_rs(const float* ss, int row, float inv_n) { return __builtin_amdgcn_rsqf(ss[row] * inv_n + NORM_EPS); }

template <int MODE = 0  > struct EpiSwiGLU {
    static constexpr bool PERM = true, AFTER_DRAIN = false;
    bf16_t* O; int ldo; const float* ss;
    __device__ __forceinline__ void operator()(const f32x4 (&acc)[2][2][4][2], const Unit& u, int wr, int wc, int fr, int fq) const {
        if (MODE == 2) return;
        const int row0 = u.pm * BM + wr * 64 + fr, col0 = u.pn * HALF + wc * 32 + 8 * fq;
        float ssv[2][4];
#pragma unroll
        for (int ai = 0; ai < 2; ++ai)
#pragma unroll
            for (int m = 0; m < 4; ++m) ssv[ai][m] = ss[row0 + ai * HALF + m * 16];
#pragma unroll
        for (int ai = 0; ai < 2; ++ai)
#pragma unroll
            for (int m = 0; m < 4; ++m) {
                const int row = row0 + ai * HALF + m * 16;
                const float r = __builtin_amdgcn_rsqf(ssv[ai][m] * (1.0f / 1024.0f) + NORM_EPS);
                const float rl = -r * LOG2E, r2 = r * r;
                float a[8];
#pragma unroll
                for (int n = 0; n < 2; ++n) {
                    const f32x4 gg = acc[ai][0][m][n], uu = acc[ai][1][m][n];
                    const f32x4 e = gg * rl, gu = (gg * uu) * r2;
#pragma unroll
                    for (int i = 0; i < 4; ++i) a[4 * n + i] = gu[i] * __builtin_amdgcn_rcpf(1.0f + __builtin_amdgcn_exp2f(e[i]));
                }
                u32x4 w; w.x = cvt_pk_bf16(a[0], a[1]); w.y = cvt_pk_bf16(a[2], a[3]); w.z = cvt_pk_bf16(a[4], a[5]); w.w = cvt_pk_bf16(a[6], a[7]);
                if (MODE == 0 || w.x == 0x7fc1abcdu) *(u32x4*)(O + (size_t)row * ldo + col0) = w;
            }
    }
};

struct EpiRes {
    static constexpr bool PERM = true, AFTER_DRAIN = false;
    bf16_t* xb; float* outf; float alpha; float* ssq; int wr_xb;
    __device__ __forceinline__ void operator()(const f32x4 (&acc)[2][2][4][2], const Unit& u, int wr, int wc, int fr, int fq) const {
        const int row0 = u.pm * BM + wr * 64 + fr, col0 = u.pn * BM + wc * 32 + 8 * fq;
#pragma unroll
        for (int ai = 0; ai < 2; ++ai) {
            u32x4 bw[4][2];
#pragma unroll
            for (int m = 0; m < 4; ++m)
#pragma unroll
                for (int bj = 0; bj < 2; ++bj) bw[m][bj] = *(const u32x4*)(xb + (size_t)(row0 + ai * HALF + m * 16) * 1024 + col0 + bj * HALF);
#pragma unroll
            for (int m = 0; m < 4; ++m) {
                const int row = row0 + ai * HALF + m * 16;
                const size_t off = (size_t)row * 1024 + col0;
                float sq = 0.f;
#pragma unroll
                for (int bj = 0; bj < 2; ++bj) {
                    const u32x4 b_ = bw[m][bj];
                    f32x4 b0, b1;
                    b0[0] = __builtin_bit_cast(float, b_.x << 16); b0[1] = __builtin_bit_cast(float, b_.x & 0xffff0000u); b0[2] = __builtin_bit_cast(float, b_.y << 16); b0[3] = __builtin_bit_cast(float, b_.y & 0xffff0000u);
                    b1[0] = __builtin_bit_cast(float, b_.z << 16); b1[1] = __builtin_bit_cast(float, b_.z & 0xffff0000u); b1[2] = __builtin_bit_cast(float, b_.w << 16); b1[3] = __builtin_bit_cast(float, b_.w & 0xffff0000u);
                    const f32x4 o0 = b0 + acc[ai][bj][m][0] * alpha, o1 = b1 + acc[ai][bj][m][1] * alpha;
                    if (outf) { *(f32x4*)(outf + off + bj * HALF) = o0; *(f32x4*)(outf + off + bj * HALF + 4) = o1; }
                    if (wr_xb) { u32x4 w; w.x = cvt_pk_bf16(o0[0], o0[1]); w.y = cvt_pk_bf16(o0[2], o0[3]); w.z = cvt_pk_bf16(o1[0], o1[1]); w.w = cvt_pk_bf16(o1[2], o1[3]);
                        *(u32x4*)(xb + off + bj * HALF) = w; }
                    sq += (o0[0] * o0[0] + o0[1] * o0[1]) + (o0[2] * o0[2] + o0[3] * o0[3]) + (o1[0] * o1[0] + o1[1] * o1[1]) + (o1[2] * o1[2] + o1[3] * o1[3]);
                }
                if (ssq) { sq += __shfl_xor(sq, 16); sq += __shfl_xor(sq, 32); if (fq == 0) atomicAdd(ssq + row, sq); }
            }
            asm volatile("" ::: "memory");
        }
    }
};

struct EpiProj {
    static constexpr bool PERM = true, AFTER_DRAIN = false;
    bf16_t* P; int ldp; const float* ss; const float* qg; const float* kg; float qscale;
    __device__ __forceinline__ void operator()(const f32x4 (&acc)[2][2][4][2], const Unit& u, int wr, int wc, int fr, int fq) const {
        const int row0 = u.pm * BM + wr * 64 + fr; const int pn = u.pn;
        float rsv[2][4];
#pragma unroll
        for (int ai = 0; ai < 2; ++ai)
#pragma unroll
            for (int m = 0; m < 4; ++m) rsv[ai][m] = ss[row0 + ai * HALF + m * 16];
        if (pn >= 6 && pn <= 9) {
            const float* gp = (pn < 8) ? qg : kg; const float gs = (pn < 8) ? qscale : 1.0f;
            float gn[2][8];
#pragma unroll
            for (int bj = 0; bj < 2; ++bj)
#pragma unroll
                for (int j = 0; j < 8; ++j) gn[bj][j] = gp[32 * bj + 8 * fq + j] * gs;
#pragma unroll
            for (int ai = 0; ai < 2; ++ai)
#pragma unroll
                for (int m = 0; m < 4; ++m) {
                    const int row = row0 + ai * HALF + m * 16;
                    const float r = __builtin_amdgcn_rsqf(rsv[ai][m] * (1.0f / 1024.0f) + NORM_EPS);
                    float v[2][8]; float sq = 0.f;
#pragma unroll
                    for (int bj = 0; bj < 2; ++bj)
#pragma unroll
                        for (int n = 0; n < 2; ++n)
#pragma unroll
                            for (int i = 0; i < 4; ++i) { const float t = acc[ai][bj][m][n][i] * r; v[bj][4 * n + i] = t; sq += t * t; }
                    sq += __shfl_xor(sq, 16); sq += __shfl_xor(sq, 32);
                    const float rr = __builtin_amdgcn_rsqf(sq * (1.0f / 64.0f) + NORM_EPS);
#pragma unroll
                    for (int bj = 0; bj < 2; ++bj) {
                        u32x4 w; w.x = cvt_pk_bf16(v[bj][0] * rr * gn[bj][0], v[bj][1] * rr * gn[bj][1]); w.y = cvt_pk_bf16(v[bj][2] * rr * gn[bj][2], v[bj][3] * rr * gn[bj][3]);
                        w.z = cvt_pk_bf16(v[bj][4] * rr * gn[bj][4], v[bj][5] * rr * gn[bj][5]); w.w = cvt_pk_bf16(v[bj][6] * rr * gn[bj][6], v[bj][7] * rr * gn[bj][7]);
                        *(u32x4*)(P + (size_t)row * ldp + pn * BM + 64 * wc + 32 * bj + 8 * fq) = w;
                    }
                }
        } else {
            const float sc = (pn == 0) ? 0.125f : 1.0f;
            const bool skip_hi = (pn == 12);
#pragma unroll
            for (int ai = 0; ai < 2; ++ai)
#pragma unroll
                for (int m = 0; m < 4; ++m) {
                    const int row = row0 + ai * HALF + m * 16;
                    const float r = __builtin_amdgcn_rsqf(rsv[ai][m] * (1.0f / 1024.0f) + NORM_EPS) * sc;
#pragma unroll
                    for (int bj = 0; bj < 2; ++bj) {
                        const f32x4 v0 = acc[ai][bj][m][0] * r, v1 = acc[ai][bj][m][1] * r;
                        u32x4 w; w.x = cvt_pk_bf16(v0[0], v0[1]); w.y = cvt_pk_bf16(v0[2], v0[3]); w.z = cvt_pk_bf16(v1[0], v1[1]); w.w = cvt_pk_bf16(v1[2], v1[3]);
                        const int c = bj * HALF + wc * 32 + 8 * fq;
                        if (!skip_hi || c < 16) *(u32x4*)(P + (size_t)row * ldp + pn * BM + c) = w;
                    }
                }
        }
    }
};

template <class Epi, class Sched, bool ALIGN_EPI = false, bool SP2 = false>
__device__ __forceinline__ void gemm_phase(PG8_LAS unsigned char* lds, const Gemm g, const Sched& S, const Epi& E) {
    const int tid = threadIdx.x, wid = __builtin_amdgcn_readfirstlane(tid >> 6), lane = tid & 63, wr = wid >> 2, wc = wid & 3, fr = lane & 15, fq = lane >> 4;
    const int K = g.K, nt = K / BK;
    unsigned voffA[2], voffB[2];
#pragma unroll
    for (int i = 0; i < 2; ++i) { int R, C; stage_rc(tid * 16 + i * 8192, R, C); const int Rb = Epi::PERM ? ((R & ~31) + perm32(R & 31)) : R;
        voffA[i] = (unsigned)(R * K + C) * 2u; voffB[i] = (unsigned)(Rb * K + C) * 2u; }
    const size_t kstep = (size_t)(BK * 2);
    const size_t hstep = (size_t)HALF * K * 2;
    const size_t tstep = 2 * hstep;
    const unsigned ldsw = (unsigned)wid * 1024u;
    const int aoff = lds_byte(wr * 64 + fr, fq * 8), boff = lds_byte(wc * 32 + fr, fq * 8);
#define PG8_SA(b, h) (((b) * 2 + (h)) * HTB)
#define PG8_SB(b, h) ((4 + (b) * 2 + (h)) * HTB)
#define PG8_STAGE(bufoff, gbase, voff) do { _Pragma("unroll") for (int _i = 0; _i < 2; ++_i) \
        __builtin_amdgcn_global_load_lds((const unsigned*)((const char*)(gbase) + (voff)[_i]), (PG8_LAS unsigned*)(lds + (bufoff) + ldsw + _i * 8192), 16, 0, 0); } while (0)
#define PG8_LDA(dst, b, h) do { _Pragma("unroll") for (int m = 0; m < 4; ++m) _Pragma("unroll") for (int k = 0; k < 2; ++k) dst[m][k] = *(const PG8_LAS bf16x8*)(lds + PG8_SA(b, h) + aoff + m * 2048 + k * 1024); } while (0)
#define PG8_LDB(dst, b, h) do { _Pragma("unroll") for (int n = 0; n < 2; ++n) _Pragma("unroll") for (int k = 0; k < 2; ++k) dst[n][k] = *(const PG8_LAS bf16x8*)(lds + PG8_SB(b, h) + boff + n * 2048 + k * 1024); } while (0)
#define PG8_MMA(ai, bj, At, Bt) do { __builtin_amdgcn_s_setprio(1); _Pragma("unroll") for (int m = 0; m < 4; ++m) _Pragma("unroll") for (int n = 0; n < 2; ++n) _Pragma("unroll") for (int k = 0; k < 2; ++k) \
        acc[ai][bj][m][n] = __builtin_amdgcn_mfma_f32_16x16x32_bf16(Bt[n][k], At[m][k], acc[ai][bj][m][n], 0, 0, 0); __builtin_amdgcn_s_setprio(0); } while (0)
#define PG8_WAIT_V(n) asm volatile("s_waitcnt vmcnt(" #n ")" ::: "memory")
#define PG8_WAIT_L(n) asm volatile("s_waitcnt lgkmcnt(" #n ")" ::: "memory")
#define PG8_BAR __builtin_amdgcn_s_barrier()
#define PG8_SCHED __builtin_amdgcn_sched_barrier(0)
    Unit cur, nxt; int ui = 0;
    if (!S.next(0, cur)) return;
    f32x4 acc[2][2][4][2];
#pragma unroll
    for (int a = 0; a < 2; ++a)
#pragma unroll
        for (int b = 0; b < 2; ++b)
#pragma unroll
            for (int m = 0; m < 4; ++m)
#pragma unroll
                for (int n = 0; n < 2; ++n) acc[a][b][m][n] = (f32x4){0.f, 0.f, 0.f, 0.f};
    bf16x8 At[4][2], B0[2][2], B1[2][2];
    const char* cA = (const char*)g.A + (size_t)cur.pm * tstep; const char* cB = (const char*)g.Bt + (size_t)cur.pn * tstep;
    S.a_ready(cur);
    if constexpr (SP2) {
        PG8_STAGE(PG8_SB(0, 0), cB, voffB); PG8_STAGE(PG8_SB(0, 1), cB + hstep, voffB); PG8_STAGE(PG8_SA(0, 0), cA, voffA); PG8_STAGE(PG8_SA(0, 1), cA + hstep, voffA);
        if (wr == 1) PG8_BAR;
        PG8_WAIT_V(2); PG8_BAR;
        PG8_STAGE(PG8_SB(1, 0), cB + kstep, voffB); PG8_STAGE(PG8_SA(1, 0), cA + kstep, voffA); PG8_STAGE(PG8_SB(1, 1), cB + hstep + kstep, voffB);
        PG8_WAIT_V(6); PG8_BAR;
    } else {
        PG8_STAGE(PG8_SB(0, 0), cB, voffB); PG8_STAGE(PG8_SA(0, 0), cA, voffA); PG8_STAGE(PG8_SB(0, 1), cB + hstep, voffB); PG8_STAGE(PG8_SA(0, 1), cA + hstep, voffA);
        if (wr == 1) PG8_BAR;
        PG8_WAIT_V(4); PG8_BAR;
        PG8_STAGE(PG8_SB(1, 0), cB + kstep, voffB); PG8_STAGE(PG8_SA(1, 0), cA + kstep, voffA); PG8_STAGE(PG8_SB(1, 1), cB + hstep + kstep, voffB);
        PG8_WAIT_V(6); PG8_BAR;
    }
    for (;;) {
        const bool has_next = S.next(ui + 1, nxt);
        const char* nA = has_next ? (const char*)g.A + (size_t)nxt.pm * tstep : cA; const char* nB = has_next ? (const char*)g.Bt + (size_t)nxt.pn * tstep : cB;
        for (int t = 0; t < nt; t += 2) {
            const bool last = (t == nt - 2);
            const char* a1 = cA + (size_t)(t + 1) * kstep;
            const char* a2 = last ? nA : cA + (size_t)(t + 2) * kstep; const char* b2 = last ? nB : cB + (size_t)(t + 2) * kstep;
            const char* a3 = a2 + kstep; const char* b3 = b2 + kstep;
            if (last && has_next) S.a_ready(nxt);
            if constexpr (SP2) {
            PG8_LDB(B0, 0, 0); PG8_LDB(B1, 0, 1); PG8_SCHED; PG8_LDA(At, 0, 0); PG8_STAGE(PG8_SA(1, 1), a1 + hstep, voffA);
            PG8_WAIT_V(8); PG8_WAIT_L(0); PG8_BAR; PG8_MMA(0, 0, At, B0); PG8_MMA(0, 1, At, B1); PG8_BAR; PG8_SCHED;
            PG8_LDA(At, 0, 1); PG8_STAGE(PG8_SB(0, 0), b2, voffB); PG8_STAGE(PG8_SB(0, 1), b2 + hstep, voffB); PG8_STAGE(PG8_SA(0, 0), a2, voffA);
            PG8_WAIT_V(8); PG8_WAIT_L(0); PG8_BAR; PG8_MMA(1, 0, At, B0); PG8_MMA(1, 1, At, B1); PG8_BAR; PG8_SCHED;
            PG8_LDB(B0, 1, 0); PG8_LDB(B1, 1, 1); PG8_SCHED; PG8_LDA(At, 1, 0); PG8_STAGE(PG8_SA(0, 1), a2 + hstep, voffA);
            PG8_WAIT_V(8); PG8_WAIT_L(0); PG8_BAR; PG8_MMA(0, 0, At, B0); PG8_MMA(0, 1, At, B1); PG8_BAR; PG8_SCHED;
            PG8_LDA(At, 1, 1); PG8_STAGE(PG8_SB(1, 0), b3, voffB); PG8_STAGE(PG8_SB(1, 1), b3 + hstep, voffB); PG8_STAGE(PG8_SA(1, 0), a3, voffA);
            PG8_WAIT_V(8); PG8_WAIT_L(0); PG8_BAR; PG8_MMA(1, 0, At, B0); PG8_MMA(1, 1, At, B1); PG8_BAR; PG8_SCHED;
            } else {
            PG8_LDB(B0, 0, 0); PG8_SCHED; PG8_LDA(At, 0, 0); PG8_STAGE(PG8_SA(1, 1), a1 + hstep, voffA);
            PG8_WAIT_L(8); PG8_BAR; PG8_WAIT_L(0); PG8_MMA(0, 0, At, B0); PG8_BAR; PG8_SCHED;
            PG8_LDB(B1, 0, 1); PG8_STAGE(PG8_SB(0, 0), b2, voffB);
            PG8_BAR; PG8_WAIT_L(0); PG8_MMA(0, 1, At, B1); PG8_BAR;
            PG8_LDA(At, 0, 1); PG8_STAGE(PG8_SA(0, 0), a2, voffA);
            PG8_BAR; PG8_WAIT_L(0); PG8_MMA(1, 0, At, B0); PG8_BAR; PG8_SCHED;
            PG8_STAGE(PG8_SB(0, 1), b2 + hstep, voffB);
            PG8_WAIT_V(6); PG8_BAR; PG8_MMA(1, 1, At, B1); PG8_BAR;
            PG8_LDB(B0, 1, 0); PG8_SCHED; PG8_LDA(At, 1, 0); PG8_STAGE(PG8_SA(0, 1), a2 + hstep, voffA);
            PG8_WAIT_L(8); PG8_BAR; PG8_WAIT_L(0); PG8_MMA(0, 0, At, B0); PG8_BAR; PG8_SCHED;
            PG8_LDB(B1, 1, 1); PG8_STAGE(PG8_SB(1, 0), b3, voffB);
            PG8_BAR; PG8_WAIT_L(0); PG8_MMA(0, 1, At, B1); PG8_BAR;
            PG8_LDA(At, 1, 1); PG8_STAGE(PG8_SA(1, 0), a3, voffA);
            PG8_BAR; PG8_WAIT_L(0); PG8_MMA(1, 0, At, B0); PG8_BAR; PG8_SCHED;
            PG8_STAGE(PG8_SB(1, 1), b3 + hstep, voffB);
            PG8_WAIT_V(6); PG8_BAR; PG8_MMA(1, 1, At, B1); PG8_BAR;
            }
        }
        if constexpr (ALIGN_EPI) { if (wr == 0) PG8_BAR; }
        if constexpr (!Epi::AFTER_DRAIN) { E(acc, cur, wr, wc, fr, fq); S.done(cur); }
        if (!has_next) break;
#pragma unroll
        for (int a = 0; a < 2; ++a)
#pragma unroll
            for (int b = 0; b < 2; ++b)
#pragma unroll
                for (int m = 0; m < 4; ++m)
#pragma unroll
                    for (int n = 0; n < 2; ++n) acc[a][b][m][n] = (f32x4){0.f, 0.f, 0.f, 0.f};
        cur = nxt; cA = nA; cB = nB; ++ui;
        if constexpr (ALIGN_EPI) { if (wr == 1) PG8_BAR; }
    }
    PG8_WAIT_V(0);
    if constexpr (!ALIGN_EPI) { if (wr == 0) PG8_BAR; }
    PG8_BAR;
    if constexpr (Epi::AFTER_DRAIN) { E.fused(acc, cur, wr, wc, fr, fq, lds, wid, lane); S.done(cur); }
#undef PG8_SA
#undef PG8_SB
#undef PG8_STAGE
#undef PG8_LDA
#undef PG8_LDB
#undef PG8_MMA
#undef PG8_WAIT_V
#undef PG8_WAIT_L
#undef PG8_BAR
#undef PG8_SCHED
}
}
#define GAS __attribute__((address_space(1)))
#define LAS __attribute__((address_space(3)))
typedef unsigned short bf16;
typedef unsigned v4u __attribute__((ext_vector_type(4)));
typedef float f32x4 __attribute__((ext_vector_type(4)));
typedef short bf16x8 __attribute__((ext_vector_type(8)));
typedef GAS unsigned gu32;
typedef GAS unsigned long long gu64;
#define RLX_AGENT __ATOMIC_RELAXED, __HIP_MEMORY_SCOPE_AGENT
#define LDS_WAIT() asm volatile("s_waitcnt lgkmcnt(0)" ::: "memory")
#define VM_WAIT() asm volatile("s_waitcnt vmcnt(0)" ::: "memory")
__device__ __forceinline__ unsigned long long rt() { return __builtin_amdgcn_s_memrealtime(); }
__device__ __forceinline__ unsigned f2bf(float f) { unsigned u = __builtin_bit_cast(unsigned, f); return (u + 0x7fffu + ((u >> 16) & 1u)) >> 16; }
__device__ __forceinline__ unsigned pk2(float lo, float hi) { return f2bf(lo) | (f2bf(hi) << 16); }

#define XB_TMO      128
#define XB_XCNT(j)  (256  + 64 * (j))
#define XB_XSUB(j)  (1280 + 64 * (j))
#define XB_XGEN(j)  (2304 + 64 * (j))
#define XB_TOP      3328
#define XB_TOPGEN   3392
#define XCD_BAR_WORDS 3456
#define XB_SPIN_CAP (1u << 18)

__device__ __forceinline__ unsigned xb_ld(unsigned* p)              { return __hip_atomic_load(p, __ATOMIC_RELAXED, __HIP_MEMORY_SCOPE_AGENT); }
__device__ __forceinline__ unsigned xb_add(unsigned* p, unsigned v) { return __hip_atomic_fetch_add(p, v, __ATOMIC_RELAXED, __HIP_MEMORY_SCOPE_AGENT); }
__device__ __forceinline__ unsigned xb_xcc_id() { return (unsigned)__builtin_amdgcn_s_getreg((3 << 11) | 20) & 0xFu; }
#define XB_SPIN(cond, bar) do { unsigned _sp = 0; while (cond) { __builtin_amdgcn_s_sleep(1); \
    if ((++_sp & 255u) == 0u) { if (xb_ld(&(bar)[XB_TMO])) break; if (_sp > XB_SPIN_CAP) { atomicAdd(&(bar)[XB_TMO], 1u); break; } } } } while (0)

struct XcdBarrier {
    unsigned* bar; unsigned x;
    volatile LAS unsigned* st;
};

__device__ __forceinline__ XcdBarrier xcd_barrier_post(unsigned* bar, volatile LAS unsigned* st) {
    XcdBarrier b; b.bar = bar; b.x = xb_xcc_id(); b.st = st;
    if (threadIdx.x == 0) (void)xb_add(&bar[XB_XCNT(b.x)], 1u);
    return b;
}
__device__ __forceinline__ void xcd_barrier_complete(unsigned* bar, unsigned x, unsigned& nloc, unsigned& nx) {
    const unsigned G = gridDim.x * gridDim.y * gridDim.z;
    unsigned sum, cnt, mine, sp = 0u;
    for (;;) {
        sum = 0u; cnt = 0u; mine = 0u;
#pragma unroll
        for (unsigned j = 0; j < 16; ++j) { const unsigned c = xb_ld(&bar[XB_XCNT(j)]); sum += c; cnt += (c > 0u) ? 1u : 0u; mine = (j == x) ? c : mine; }
        if (sum == G) break;
        __builtin_amdgcn_s_sleep(1);
        if ((++sp & 255u) == 0u) { if (xb_ld(&bar[XB_TMO])) break; if (sp > XB_SPIN_CAP) { atomicAdd(&bar[XB_TMO], 1u); break; } }
    }
    nloc = mine > 0u ? mine : 1u; nx = cnt > 0u ? cnt : 1u;
}

__device__ __forceinline__ void xcd_barrier(const XcdBarrier& b) {
    asm volatile("s_waitcnt vmcnt(0)" ::: "memory");
    __syncthreads();
    if (threadIdx.x == 0) {
        unsigned* bar = b.bar;
        __builtin_amdgcn_s_waitcnt(0);
        unsigned nloc = b.st[0], nx = b.st[1];
        if (nloc == 0u) { xcd_barrier_complete(bar, b.x, nloc, nx); b.st[0] = nloc; b.st[1] = nx; }
        const unsigned old = xb_add(&bar[XB_XSUB(b.x)], 1u);
        const unsigned gen = old / nloc;
        if (old + 1u == (gen + 1u) * nloc) {
            __builtin_amdgcn_fence(__ATOMIC_RELEASE, "agent");
            asm volatile("s_waitcnt vmcnt(0)" ::: "memory");
            const unsigned og = xb_add(&bar[XB_TOP], 1u);
            const unsigned tg = og / nx;
            if (og + 1u == (tg + 1u) * nx) xb_add(&bar[XB_TOPGEN], 1u);
            else XB_SPIN(xb_ld(&bar[XB_TOPGEN]) == tg, bar);
            __builtin_amdgcn_fence(__ATOMIC_ACQUIRE, "agent");
            xb_add(&bar[XB_XGEN(b.x)], 1u);
            asm volatile("s_waitcnt vmcnt(0)" ::: "memory");
        } else {
            XB_SPIN(xb_ld(&bar[XB_XGEN(b.x)]) == gen, bar);
            __builtin_amdgcn_fence(__ATOMIC_ACQUIRE, "agent");
            asm volatile("s_waitcnt vmcnt(0)" ::: "memory");
        }
    }
    __syncthreads();
}

constexpr int NWAVES = 8;
constexpr int BATCH = 16, SEQ = 4096, DM = 1024, MROWS = BATCH * SEQ, DFF = 2816;
constexpr int GLA_H = 4, GLA_DK = 64, GLA_DV = 128, GLA_RANK = 16, SB_H = 8, SB_D = 64;
constexpr int NPROJ = 3328;
constexpr int PC_GQ = 0, PC_GK = 256, PC_GV = 512, PC_GG = 1024, PC_SQ = 1536, PC_SK = 2048, PC_SV = 2560, PC_LR = 3072;
constexpr int SRC_GQ = 0, SRC_GK = 256, SRC_GV = 512, SRC_GG = 1024, SRC_LR = 1536, SRC_SQ = 1552, SRC_SK = 2064, SRC_SV = 2576, D_IN = 3088;
constexpr float EPS = 1e-6f;
constexpr float SBQ_SCALE = 0.125f * 1.4426950408889634f;

constexpr size_t MiB = 1u << 20;
constexpr size_t WS_CTL = 0, CTL_ZERO_BYTES = 2 * MiB;
constexpr size_t WS_SS1 = 1 * MiB, WS_SS2 = 1 * MiB + 256 * 1024, WS_SS0 = 1 * MiB + 512 * 1024;
constexpr size_t WS_W1 = 2 * MiB;
constexpr size_t WS_WD1 = WS_W1 + (size_t)2 * DFF * DM * 2;
constexpr size_t WS_WIN = WS_WD1 + (size_t)DM * DFF * 2;
constexpr size_t WS_WOUT = WS_WIN + (size_t)NPROJ * DM * 2;
constexpr size_t WS_W2 = WS_WOUT + (size_t)DM * DM * 2;
constexpr size_t WS_WD2 = WS_W2 + (size_t)2 * DFF * DM * 2;
constexpr size_t WS_WEND = WS_WD2 + (size_t)DM * DFF * 2;
static_assert(WS_WEND <= 64 * MiB, "weights");
constexpr size_t WS_XB = 64 * MiB;
constexpr size_t WS_MIX = 192 * MiB;
constexpr size_t WS_BIG = 320 * MiB;
constexpr size_t WS_END = WS_BIG + (size_t)MROWS * NPROJ * 2;
constexpr int CW_BAR = 4096;
constexpr int CW_WORK = 1024;

constexpr int RING_OFF = 0, RING_BYTES = 155648;
constexpr int LDSCTL_OFF = RING_BYTES, MISC_OFF = LDSCTL_OFF + 320;
constexpr int LDS_BYTES = 163840;


namespace sb {
typedef short bf16x8 __attribute__((ext_vector_type(8)));
typedef short s16x4 __attribute__((ext_vector_type(4)));
typedef float f32x16 __attribute__((ext_vector_type(16)));
typedef unsigned u32x4 __attribute__((ext_vector_type(4)));
typedef unsigned short bf16;
constexpr int QB = 256, KVBLK = 64, SLOTB = 8192;
constexpr int NRING = 6, LDS_OST = NRING * 2 * SLOTB, LDS_BYTES = LDS_OST + 8 * 4096;
__device__ __forceinline__ int crow(int r, int hi) { return (r & 3) + 8 * (r >> 2) + 4 * hi; }
__device__ __forceinline__ void glds16(const void* gsrc, unsigned lds_dst) { unsigned keep;
    asm volatile("s_mov_b32 %0, m0\n\ts_mov_b32 m0, %2\n\ts_nop 0\n\tglobal_load_lds_dwordx4 %1, off\n\ts_mov_b32 m0, %0" : "=&s"(keep) : "v"(gsrc), "s"(lds_dst) : "memory"); }
typedef float f32x2_t __attribute__((ext_vector_type(2))); typedef __bf16 bf16x2_t __attribute__((ext_vector_type(2)));
__device__ __forceinline__ unsigned cvtpk(float lo, float hi) { f32x2_t v = {lo, hi}; bf16x2_t b = __builtin_convertvector(v, bf16x2_t); return __builtin_bit_cast(unsigned, b); }
typedef short v4i16_t __attribute__((ext_vector_type(4)));
#define SB_LAS __attribute__((address_space(3)))
__device__ __forceinline__ s16x4 trd(const SB_LAS unsigned char* p) { return __builtin_bit_cast(s16x4, __builtin_amdgcn_ds_read_tr16_b64_v4i16((SB_LAS v4i16_t*)p)); }
#define SB_SBAR() __builtin_amdgcn_sched_barrier(0)
#define SB_WAIT_BAR(N) asm volatile("s_waitcnt vmcnt(" #N ") lgkmcnt(0)\n\ts_barrier" ::: "memory")

__device__ __forceinline__ void qkt(f32x16& p0, f32x16& p1, const char* Kslot, const bf16x8* qr, int r32, int hi) {
    const char* kb = Kslot + hi * 1024 + r32 * 16;
    const f32x16 z = {};
#pragma unroll
    for (int d0 = 0; d0 < 4; ++d0) {
        const bf16x8 b0 = *reinterpret_cast<const bf16x8*>(kb + d0 * 2048);
        const bf16x8 b1 = *reinterpret_cast<const bf16x8*>(kb + d0 * 2048 + 512);
        if (d0 == 0) { p0 = __builtin_amdgcn_mfma_f32_32x32x16_bf16(b0, qr[0], z, 0, 0, 0); p1 = __builtin_amdgcn_mfma_f32_32x32x16_bf16(b1, qr[0], z, 0, 0, 0); }
        else { p0 = __builtin_amdgcn_mfma_f32_32x32x16_bf16(b0, qr[d0], p0, 0, 0, 0); p1 = __builtin_amdgcn_mfma_f32_32x32x16_bf16(b1, qr[d0], p1, 0, 0, 0); } }
}
__device__ __forceinline__ void pv(f32x16* o, int vb, bf16x8 pa0, bf16x8 pa1, bf16x8 pa2, bf16x8 pa3) {
#pragma unroll
    for (int d0 = 0; d0 < 2; ++d0) { s16x4 lo[4], hi[4];
#pragma unroll
        for (int ks = 0; ks < 4; ++ks) {
            asm volatile("ds_read_b64_tr_b16 %0,%1 offset:%c2" : "=&v"(lo[ks]) : "v"(vb), "i"(d0 * 4096 + ks * 1024) : "memory");
            asm volatile("ds_read_b64_tr_b16 %0,%1 offset:%c2" : "=&v"(hi[ks]) : "v"(vb), "i"(d0 * 4096 + ks * 1024 + 512) : "memory"); }
        asm volatile("s_waitcnt lgkmcnt(0)" ::: "memory"); SB_SBAR();
#define SB_PK(k) (bf16x8){lo[k][0], lo[k][1], lo[k][2], lo[k][3], hi[k][0], hi[k][1], hi[k][2], hi[k][3]}
        o[d0] = __builtin_amdgcn_mfma_f32_32x32x16_bf16(pa0, SB_PK(0), o[d0], 0, 0, 0);
        o[d0] = __builtin_amdgcn_mfma_f32_32x32x16_bf16(pa1, SB_PK(1), o[d0], 0, 0, 0);
        o[d0] = __builtin_amdgcn_mfma_f32_32x32x16_bf16(pa2, SB_PK(2), o[d0], 0, 0, 0);
        o[d0] = __builtin_amdgcn_mfma_f32_32x32x16_bf16(pa3, SB_PK(3), o[d0], 0, 0, 0);
#undef SB_PK
    }
}

template <bool EXIT>
__device__ __forceinline__ void sb_unit(int b, int h, int qb, const bf16* P, int pitch, int cq, int ck, int cv, bf16* O, int opitch, int co, int seq, char* shm, __attribute__((address_space(3))) unsigned char* lds3) {
    const int tid = threadIdx.x, lane = tid & 63, r32 = lane & 31, hi = lane >> 5; const int wid = __builtin_amdgcn_readfirstlane(tid >> 6);
    const long rowbase = (long)b * seq; const int q0 = qb * QB, qw = q0 + wid * 32;
    const bf16* Qw = P + (rowbase + qw) * pitch + cq + h * 64;
    const bf16* Kh = P + rowbase * pitch + ck + h * 64; const bf16* Vh = P + rowbase * pitch + cv + h * 64;
    const unsigned lds0 = (unsigned)(uintptr_t)shm;
    const bf16* ksrc = Kh + (long)lane * pitch + wid * 8;
    const bf16* vsrc = Vh + (long)(16 * (wid & 3) + (lane >> 2)) * pitch + (wid >> 2) * 32 + (lane & 3) * 8;
    const unsigned kdst = lds0 + wid * 1024, vdst = lds0 + SLOTB + wid * 1024;
#define SB_DMA_KV(t, pos) do { const int t_ = (t) < 0 ? 0 : (t); \
        glds16(ksrc + (long)t_ * KVBLK * pitch, (unsigned)__builtin_amdgcn_readfirstlane(kdst + (pos) * 2 * SLOTB)); \
        glds16(vsrc + (long)t_ * KVBLK * pitch, (unsigned)__builtin_amdgcn_readfirstlane(vdst + (pos) * 2 * SLOTB)); } while (0)
    const int vb0 = (int)(lds0 + SLOTB) + ((lane >> 4) & 1) * 32 + (lane & 3) * 8 + (4 * hi + ((lane & 15) >> 2)) * 64;
    const int pw_ = wid >> 1, tb = 4 * qb;
    volatile __attribute__((address_space(3))) int* DONEW = (volatile __attribute__((address_space(3))) int*)(lds3 + LDS_BYTES);
    if (lane == 0) DONEW[wid] = 1000;
    bf16x8 qr[4];
#pragma unroll
    for (int d0 = 0; d0 < 4; ++d0) qr[d0] = *reinterpret_cast<const bf16x8*>(&Qw[(long)r32 * pitch + d0 * 16 + hi * 8]);
    SB_DMA_KV(tb + 3, 0); SB_DMA_KV(tb + 2, 1); SB_DMA_KV(tb + 1, 2); SB_DMA_KV(tb, 3); SB_DMA_KV(tb - 1, 4);
    bf16x8 triA[2], onesA;
#pragma unroll
    for (int s = 0; s < 2; ++s)
#pragma unroll
        for (int j = 0; j < 8; ++j) { const int kk = 16 * s + 8 * (j >> 2) + 4 * hi + (j & 3); triA[s][j] = (kk > r32) ? (short)0xBF80 : (short)0; }
#pragma unroll
    for (int j = 0; j < 8; ++j) onesA[j] = (short)0xBF80;
    f32x16 o[2]; o[0] = f32x16{}; o[1] = f32x16{};
    float R = 0.f;
    const int tq = qw + r32;
    bool mydone = false;
    asm volatile("" :: "v"(qr[0]), "v"(qr[1]), "v"(qr[2]), "v"(qr[3]));
    const int nsteps = tb + 4;
    int posn = 5;
    int posw = 3 - pw_;
    for (int i = 0; i < nsteps; ++i) {
        SB_WAIT_BAR(2);
        if (EXIT) { int cnt = 0;
#pragma unroll
            for (int w = 0; w < 8; ++w) cnt += (DONEW[w] < i) ? 1 : 0;
            if (cnt == 8) break; }
        SB_DMA_KV(tb - (i + 2), posn);
        posn = (posn == 5) ? 0 : posn + 1;
        const int t = tb + pw_ - i;
        if (!mydone && t < 0) { mydone = true; if (lane == 0) DONEW[wid] = i; }
        if (!mydone) {
            const int slot = posw * 2 * SLOTB;
            auto tile = [&](auto diag_c) {
                constexpr bool DIAG = decltype(diag_c)::value;
                f32x16 p0, p1;
                qkt(p0, p1, shm + slot, qr, r32, hi);
                bf16x8 vfr[8];
                { const SB_LAS unsigned char* vp = lds3 + slot + SLOTB + ((lane >> 4) & 1) * 32 + (lane & 3) * 8 + (4 * hi + ((lane & 15) >> 2)) * 64;
#pragma unroll
                  for (int f = 0; f < 8; ++f) { const s16x4 lo = trd(vp + (f >> 2) * 4096 + (f & 3) * 1024), hh = trd(vp + (f >> 2) * 4096 + (f & 3) * 1024 + 512);
                      vfr[f] = (bf16x8){lo[0], lo[1], lo[2], lo[3], hh[0], hh[1], hh[2], hh[3]}; } }
                const int kbase = t * KVBLK + 4 * hi;
                float rs = 0.f;
                f32x16 c0, c1;
#pragma unroll
                for (int r = 0; r < 16; ++r) {
                    float s0 = __builtin_amdgcn_logf(1.0f + __builtin_amdgcn_exp2f(p0[r]));
                    float s1 = __builtin_amdgcn_logf(1.0f + __builtin_amdgcn_exp2f(p1[r]));
                    if (DIAG) { const int kv = kbase + (r & 3) + 8 * (r >> 2); if (kv >= tq) s0 = 0.f; if (kv + 32 >= tq) s1 = 0.f; }
                    c0[r] = (p0[r] - s0) + R; c1[r] = (p1[r] - s1) + R;
                    p0[r] = s0; p1[r] = s1; rs += s0; rs += s1;
                }
                u32x4 sb0a, sb0b, sb1a, sb1b;
                sb0a = (u32x4){cvtpk(p0[0], p0[1]), cvtpk(p0[2], p0[3]), cvtpk(p0[4], p0[5]), cvtpk(p0[6], p0[7])};
                sb0b = (u32x4){cvtpk(p0[8], p0[9]), cvtpk(p0[10], p0[11]), cvtpk(p0[12], p0[13]), cvtpk(p0[14], p0[15])};
                sb1a = (u32x4){cvtpk(p1[0], p1[1]), cvtpk(p1[2], p1[3]), cvtpk(p1[4], p1[5]), cvtpk(p1[6], p1[7])};
                sb1b = (u32x4){cvtpk(p1[8], p1[9]), cvtpk(p1[10], p1[11]), cvtpk(p1[12], p1[13]), cvtpk(p1[14], p1[15])};
#define SB_F(x) __builtin_bit_cast(bf16x8, x)
                c0 = __builtin_amdgcn_mfma_f32_32x32x16_bf16(triA[0], SB_F(sb0a), c0, 0, 0, 0);
                c1 = __builtin_amdgcn_mfma_f32_32x32x16_bf16(triA[0], SB_F(sb1a), c1, 0, 0, 0);
                c0 = __builtin_amdgcn_mfma_f32_32x32x16_bf16(triA[1], SB_F(sb0b), c0, 0, 0, 0);
                c1 = __builtin_amdgcn_mfma_f32_32x32x16_bf16(triA[1], SB_F(sb1b), c1, 0, 0, 0);
                c0 = __builtin_amdgcn_mfma_f32_32x32x16_bf16(onesA, SB_F(sb1a), c0, 0, 0, 0);
                c0 = __builtin_amdgcn_mfma_f32_32x32x16_bf16(onesA, SB_F(sb1b), c0, 0, 0, 0);
                { auto rr = __builtin_amdgcn_permlane32_swap(__float_as_uint(rs), __float_as_uint(rs), false, false); rs = __uint_as_float(rr[0]) + __uint_as_float(rr[1]); }
                R -= rs;
                if (EXIT) { if (__all(R < -134.0f)) { mydone = true; if (lane == 0) DONEW[wid] = i; } }
#pragma unroll
                for (int r = 0; r < 16; ++r) {
                    float w0 = __builtin_amdgcn_exp2f(c0[r]), w1 = __builtin_amdgcn_exp2f(c1[r]);
                    if (DIAG) { const int kv = kbase + (r & 3) + 8 * (r >> 2); if (kv >= tq) w0 = 0.f; if (kv + 32 >= tq) w1 = 0.f; }
                    p0[r] = w0; p1[r] = w1;
                }
                u32x4 pw0, pw1, pw2, pw3;
                pw0 = (u32x4){cvtpk(p0[0], p0[1]), cvtpk(p0[2], p0[3]), cvtpk(p0[4], p0[5]), cvtpk(p0[6], p0[7])};
                pw1 = (u32x4){cvtpk(p0[8], p0[9]), cvtpk(p0[10], p0[11]), cvtpk(p0[12], p0[13]), cvtpk(p0[14], p0[15])};
                pw2 = (u32x4){cvtpk(p1[0], p1[1]), cvtpk(p1[2], p1[3]), cvtpk(p1[4], p1[5]), cvtpk(p1[6], p1[7])};
                pw3 = (u32x4){cvtpk(p1[8], p1[9]), cvtpk(p1[10], p1[11]), cvtpk(p1[12], p1[13]), cvtpk(p1[14], p1[15])};
                o[0] = __builtin_amdgcn_mfma_f32_32x32x16_bf16(SB_F(pw0), vfr[0], o[0], 0, 0, 0); o[1] = __builtin_amdgcn_mfma_f32_32x32x16_bf16(SB_F(pw0), vfr[4], o[1], 0, 0, 0);
                o[0] = __builtin_amdgcn_mfma_f32_32x32x16_bf16(SB_F(pw1), vfr[1], o[0], 0, 0, 0); o[1] = __builtin_amdgcn_mfma_f32_32x32x16_bf16(SB_F(pw1), vfr[5], o[1], 0, 0, 0);
                o[0] = __builtin_amdgcn_mfma_f32_32x32x16_bf16(SB_F(pw2), vfr[2], o[0], 0, 0, 0); o[1] = __builtin_amdgcn_mfma_f32_32x32x16_bf16(SB_F(pw2), vfr[6], o[1], 0, 0, 0);
                o[0] = __builtin_amdgcn_mfma_f32_32x32x16_bf16(SB_F(pw3), vfr[3], o[0], 0, 0, 0); o[1] = __builtin_amdgcn_mfma_f32_32x32x16_bf16(SB_F(pw3), vfr[7], o[1], 0, 0, 0);
#undef SB_F
            };
            if (i == 0) tile(std::true_type{}); else tile(std::false_type{});
        }
        posw = (posw == 5) ? 0 : posw + 1;
    }
    asm volatile("s_waitcnt vmcnt(0)" ::: "memory");
    bf16* Ow = O + (rowbase + qw) * opitch + co + h * 64;
    { bf16* stg = (bf16*)(shm + LDS_OST) + wid * 2048;
#pragma unroll
      for (int r = 0; r < 16; ++r) { const int orow = crow(r, hi);
#pragma unroll
          for (int d0 = 0; d0 < 2; ++d0) stg[orow * 64 + d0 * 32 + r32] = (bf16)(cvtpk(o[d0][r], 0.f) & 0xffffu); }
      asm volatile("s_waitcnt lgkmcnt(0)" ::: "memory");
#pragma unroll
      for (int i = 0; i < 4; ++i) { const int row = i * 8 + (lane >> 3), ch = lane & 7; const u32x4 v = *(const u32x4*)(stg + row * 64 + ch * 8); *(u32x4*)(Ow + (long)row * opitch + ch * 8) = v; } }
    asm volatile("s_waitcnt lgkmcnt(0)\n\ts_barrier" ::: "memory");
#undef SB_DMA_KV
}
#undef SB_LAS
#undef SB_SBAR
#undef SB_WAIT_BAR
}

namespace gla {
typedef short bf16x8 __attribute__((ext_vector_type(8)));
typedef short s16x4 __attribute__((ext_vector_type(4)));
typedef float f32x16 __attribute__((ext_vector_type(16)));
typedef float f32x4 __attribute__((ext_vector_type(4)));
typedef unsigned u32x4 __attribute__((ext_vector_type(4)));
typedef unsigned short bf16;
#define GLA_LAS __attribute__((address_space(3)))
#define GLA_GAS __attribute__((address_space(1)))
#define GLA_SCHED() __builtin_amdgcn_sched_barrier(0)
#define GLA_BAR() asm volatile("s_waitcnt lgkmcnt(0)\n\ts_barrier" ::: "memory")
constexpr float LOG2E = 1.4426950408889634f;
constexpr int REC_BYTES = 32768, REC_QD = 0, REC_KI = 8192, REC_KE = 16384, REC_DEC = 24576;
constexpr int BLS = 68;
constexpr int PL_CW = 0, PL_CT = 4096, PL_BL = 8192;
constexpr int SET_BYTES = 43008, S_QD = 0, S_KI = 8192, S_KE = 16384, S_VT = 24576, S_DEC = 40960;
constexpr int L_OS = 2 * SET_BYTES, L_GT = L_OS + 32768, L_GN = L_GT + 32768, L_END = L_GN + 512;
typedef float f32x2_t __attribute__((ext_vector_type(2))); typedef __bf16 bf16x2_t __attribute__((ext_vector_type(2)));
__device__ __forceinline__ unsigned cvtpk(float lo, float hi) { f32x2_t v = {lo, hi}; bf16x2_t b = __builtin_convertvector(v, bf16x2_t); return __builtin_bit_cast(unsigned, b); }
__device__ __forceinline__ float blo(unsigned w) { return __builtin_bit_cast(float, w << 16); }
__device__ __forceinline__ float bhi(unsigned w) { return __builtin_bit_cast(float, w & 0xffff0000u); }
__device__ __forceinline__ int crow(int r, int hi) { return (r & 3) + 8 * (r >> 2) + 4 * hi; }
typedef short v4i16_t __attribute__((ext_vector_type(4)));
__device__ __forceinline__ s16x4 trd(const GLA_LAS unsigned char* p) { return __builtin_bit_cast(s16x4, __builtin_amdgcn_ds_read_tr16_b64_v4i16((GLA_LAS v4i16_t*)p)); }
__device__ __forceinline__ bf16x8 pack8(const f32x16& x, int base) {
    u32x4 w = {cvtpk(x[base + 0], x[base + 1]), cvtpk(x[base + 2], x[base + 3]), cvtpk(x[base + 4], x[base + 5]), cvtpk(x[base + 6], x[base + 7])};
    return __builtin_bit_cast(bf16x8, w); }
__device__ __forceinline__ void unpack8(const u32x4& w, float* f) { f[0] = blo(w.x); f[1] = bhi(w.x); f[2] = blo(w.y); f[3] = bhi(w.y); f[4] = blo(w.z); f[5] = bhi(w.z); f[6] = blo(w.w); f[7] = bhi(w.w); }
__device__ __forceinline__ void glds16(const void* gsrc, unsigned lds_dst) { unsigned keep;
    asm volatile("s_mov_b32 %0, m0\n\ts_mov_b32 m0, %2\n\ts_nop 0\n\tglobal_load_lds_dwordx4 %1, off\n\ts_mov_b32 m0, %0" : "=&s"(keep) : "v"(gsrc), "s"(lds_dst) : "memory"); }

struct PrepLoads { u32x4 lrA0, lrA1, q8[4], k8[4]; };
__device__ __forceinline__ void prep_load(PrepLoads& L, int u, const bf16* P, int pitch, int cq, int ck, int clr, int seq) {
    const int tid = threadIdx.x, lane = tid & 63, r32 = lane & 31, hi = lane >> 5; const int wid = __builtin_amdgcn_readfirstlane(tid >> 6);
    const int tok = tid >> 3, sub = tid & 7, cj = wid >> 1;
    const int g = u & 15, bh = u >> 4, b = bh >> 2, h = bh & 3;
    const size_t row0 = (size_t)b * seq + (size_t)g * 256;
    const bf16* lrow = P + (row0 + cj * 64 + r32) * pitch + clr + 8 * hi;
    L.lrA0 = *(const GLA_GAS u32x4*)(lrow); L.lrA1 = *(const GLA_GAS u32x4*)(lrow + (size_t)32 * pitch);
#pragma unroll
    for (int j = 0; j < 4; ++j) { const bf16* pr = P + (row0 + j * 64 + tok) * pitch; L.q8[j] = *(const GLA_GAS u32x4*)(pr + cq + h * 64 + sub * 8); L.k8[j] = *(const GLA_GAS u32x4*)(pr + ck + h * 64 + sub * 8); }
}
__device__ __forceinline__ void prep_unit(const PrepLoads& L, int u, unsigned char* REC, const float* wup, const float* bgk, GLA_LAS unsigned char* lds) {
    const int tid = threadIdx.x, lane = tid & 63, r32 = lane & 31, hi = lane >> 5; const int wid = __builtin_amdgcn_readfirstlane(tid >> 6);
    const int tok = tid >> 3, sub = tid & 7;
    const int cj = wid >> 1, dkh = wid & 1;
    const int g = u & 15, bh = u >> 4, b = bh >> 2, h = bh & 3;
    GLA_LAS unsigned char* CW = lds + PL_CW; GLA_LAS unsigned char* CT = lds + PL_CT; GLA_LAS float* BL = (GLA_LAS float*)(lds + PL_BL);
    const u32x4 lrA0 = L.lrA0, lrA1 = L.lrA1;
    float bgl;
    { const int dkc = h * 64 + 32 * dkh + r32; bgl = bgk[dkc] * LOG2E;
      if (wid < 2) { bf16x8 wB_hi, wB_lo;
#pragma unroll
          for (int j = 0; j < 8; ++j) { const float wv = wup[(8 * hi + j) * 256 + dkc] * LOG2E; const unsigned hb = cvtpk(wv, 0.f) & 0xffffu; const float lov = wv - __builtin_bit_cast(float, hb << 16);
              wB_hi[j] = (short)hb; wB_lo[j] = (short)(cvtpk(lov, 0.f) & 0xffffu); }
          *(GLA_LAS bf16x8*)(CW + wid * 2048 + lane * 16) = wB_hi; *(GLA_LAS bf16x8*)(CW + wid * 2048 + 1024 + lane * 16) = wB_lo; }
      if (wid == 2) {
#pragma unroll
          for (int s = 0; s < 2; ++s) { bf16x8 t;
#pragma unroll
              for (int j = 0; j < 8; ++j) { const int kk = 16 * s + 8 * (j >> 2) + 4 * hi + (j & 3); t[j] = (kk <= r32) ? (short)0x3F80 : (short)0; }
              *(GLA_LAS bf16x8*)(CT + s * 1024 + lane * 16) = t; } } }
    GLA_BAR();
    unsigned char* rec0 = REC + ((size_t)(b * 4 + h) * 64 + (size_t)g * 4) * REC_BYTES;
    {   const bf16x8 wB_hi = *(const GLA_LAS bf16x8*)(CW + dkh * 2048 + lane * 16), wB_lo = *(const GLA_LAS bf16x8*)(CW + dkh * 2048 + 1024 + lane * 16);
        const bf16x8 tri0 = *(const GLA_LAS bf16x8*)(CT + lane * 16), tri1 = *(const GLA_LAS bf16x8*)(CT + 1024 + lane * 16);
        bf16x8 onesP;
#pragma unroll
        for (int j = 0; j < 8; ++j) onesP[j] = (short)0x3F80;
        GLA_LAS float* BLc = BL + cj * 64 * BLS;
        f32x16 b0 = {}, b1 = {};
#pragma unroll
        for (int T = 0; T < 2; ++T) {
            f32x16 x;
#pragma unroll
            for (int r = 0; r < 16; ++r) x[r] = bgl;
            const bf16x8 af = __builtin_bit_cast(bf16x8, T ? lrA1 : lrA0);
            x = __builtin_amdgcn_mfma_f32_32x32x16_bf16(af, wB_hi, x, 0, 0, 0);
            x = __builtin_amdgcn_mfma_f32_32x32x16_bf16(af, wB_lo, x, 0, 0, 0);
#pragma unroll
            for (int r = 0; r < 16; ++r) x[r] = (fminf(x[r], 0.f) - __builtin_amdgcn_logf(1.0f + __builtin_amdgcn_exp2f(-fabsf(x[r])))) * (1.0f / 16.0f);
            const bf16x8 hA = pack8(x, 0), hB = pack8(x, 8);
#pragma unroll
            for (int r = 0; r < 16; ++r) x[r] -= __builtin_bit_cast(float, (unsigned)(unsigned short)((r < 8) ? hA[r & 7] : hB[r & 7]) << 16);
            const bf16x8 lA = pack8(x, 0), lB = pack8(x, 8);
            if (T == 0) {
                b0 = __builtin_amdgcn_mfma_f32_32x32x16_bf16(tri0, hA, b0, 0, 0, 0); b1 = __builtin_amdgcn_mfma_f32_32x32x16_bf16(onesP, hA, b1, 0, 0, 0);
                b0 = __builtin_amdgcn_mfma_f32_32x32x16_bf16(tri1, hB, b0, 0, 0, 0); b1 = __builtin_amdgcn_mfma_f32_32x32x16_bf16(onesP, hB, b1, 0, 0, 0);
                b0 = __builtin_amdgcn_mfma_f32_32x32x16_bf16(tri0, lA, b0, 0, 0, 0); b1 = __builtin_amdgcn_mfma_f32_32x32x16_bf16(onesP, lA, b1, 0, 0, 0);
                b0 = __builtin_amdgcn_mfma_f32_32x32x16_bf16(tri1, lB, b0, 0, 0, 0); b1 = __builtin_amdgcn_mfma_f32_32x32x16_bf16(onesP, lB, b1, 0, 0, 0);
#pragma unroll
                for (int r = 0; r < 16; ++r) BLc[crow(r, hi) * BLS + 32 * dkh + r32] = b0[r];
            } else {
                b1 = __builtin_amdgcn_mfma_f32_32x32x16_bf16(tri0, hA, b1, 0, 0, 0); b1 = __builtin_amdgcn_mfma_f32_32x32x16_bf16(tri1, hB, b1, 0, 0, 0);
                b1 = __builtin_amdgcn_mfma_f32_32x32x16_bf16(tri0, lA, b1, 0, 0, 0); b1 = __builtin_amdgcn_mfma_f32_32x32x16_bf16(tri1, lB, b1, 0, 0, 0);
#pragma unroll
                for (int r = 0; r < 16; ++r) BLc[(32 + crow(r, hi)) * BLS + 32 * dkh + r32] = b1[r];
                if (hi) *(GLA_GAS float*)(rec0 + (size_t)cj * REC_BYTES + REC_DEC + (32 * dkh + r32) * 4) = __builtin_amdgcn_exp2f(b1[15]);
            }
        }
    }
    GLA_BAR();
#pragma unroll
    for (int j = 0; j < 4; ++j) {
        const GLA_LAS float* BLc = BL + j * 64 * BLS;
        float qf[8], kf[8]; unpack8(L.q8[j], qf); unpack8(L.k8[j], kf);
        float qd[8], ki[8];
#pragma unroll
        for (int e = 0; e < 8; ++e) { const float bb = BLc[tok * BLS + 8 * sub + e];
            qd[e] = qf[e] * __builtin_amdgcn_exp2f(bb); ki[e] = kf[e] * __builtin_amdgcn_exp2f(-bb); }
        unsigned char* rec = rec0 + (size_t)j * REC_BYTES;
        *(GLA_GAS u32x4*)(rec + REC_QD + sub * 1024 + tok * 16) = (u32x4){cvtpk(qd[0], qd[1]), cvtpk(qd[2], qd[3]), cvtpk(qd[4], qd[5]), cvtpk(qd[6], qd[7])};
        *(GLA_GAS u32x4*)(rec + REC_KE + (sub >> 2) * 4096 + tok * 64 + (sub & 3) * 16) = (u32x4){cvtpk(ki[0], ki[1]), cvtpk(ki[2], ki[3]), cvtpk(ki[4], ki[5]), cvtpk(ki[6], ki[7])};
    }
    GLA_BAR();
}

__device__ __forceinline__ void gla_unit(int b, int h, const bf16* P, int pitch, int cv, int cg, const unsigned char* REC, bf16* MIX, int opitch, int seq,
                                         const float* gon, GLA_LAS unsigned char* lds, const char* shm, bool hot = false) {
    const int tid = threadIdx.x, lane = tid & 63, r32 = lane & 31, hi = lane >> 5; const int wid = __builtin_amdgcn_readfirstlane(tid >> 6);
    const int tok = tid >> 3, sub = tid & 7;
    const int th = wid >> 2, c = wid & 3;
    GLA_LAS float* GN = (GLA_LAS float*)(lds + L_GN);
    if (tid < 128) GN[tid] = gon[tid];
    const unsigned lds0 = (unsigned)(uintptr_t)shm;
    const unsigned char* rec0 = REC + (size_t)(b * 4 + h) * 64 * REC_BYTES;
    const bf16* prow = P + ((size_t)b * seq + tok) * pitch;
    const bf16* vsrc0 = P + ((size_t)b * seq + 16 * ((2 * wid) & 3) + (lane >> 2)) * pitch + cv + h * 128 + 32 * ((2 * wid) >> 2) + 8 * (lane & 3);
    const bf16* vsrc1 = P + ((size_t)b * seq + 16 * ((2 * wid + 1) & 3) + (lane >> 2)) * pitch + cv + h * 128 + 32 * ((2 * wid + 1) >> 2) + 8 * (lane & 3);
#define GLA_DMA(n, set) do { const unsigned char* r_ = rec0 + (size_t)(n) * REC_BYTES; const unsigned sb_ = lds0 + (set) * SET_BYTES; \
        glds16(r_ + REC_QD + wid * 1024 + lane * 16, (unsigned)__builtin_amdgcn_readfirstlane(sb_ + S_QD + wid * 1024)); \
        glds16(r_ + REC_KE + wid * 1024 + lane * 16, (unsigned)__builtin_amdgcn_readfirstlane(sb_ + S_KE + wid * 1024)); \
        glds16(vsrc0 + (size_t)(n) * 64 * pitch, (unsigned)__builtin_amdgcn_readfirstlane(sb_ + S_VT + (2 * wid) * 1024)); \
        glds16(vsrc1 + (size_t)(n) * 64 * pitch, (unsigned)__builtin_amdgcn_readfirstlane(sb_ + S_VT + (2 * wid + 1) * 1024)); \
        if (wid == 0) glds16(r_ + REC_DEC + lane * 16, (unsigned)__builtin_amdgcn_readfirstlane(sb_ + S_DEC)); } while (0)
    const bf16* gsrc = P + ((size_t)b * seq + 8 * wid + (lane >> 4)) * pitch + cg + h * 128 + 8 * (lane & 15);
#define GLA_DMA_GATE(n, gb) do { const unsigned gd_ = lds0 + L_GT + (gb) * 16384 + (2 * wid) * 1024; \
        glds16(gsrc + (size_t)(n) * 64 * pitch, (unsigned)__builtin_amdgcn_readfirstlane(gd_)); \
        glds16(gsrc + ((size_t)(n) * 64 + 4) * pitch, (unsigned)__builtin_amdgcn_readfirstlane(gd_ + 1024)); } while (0)
    f32x16 S0 = {}, S1 = {};
    const int trl = ((lane >> 4) & 1) * 32 + (lane & 3) * 8 + (4 * hi + ((lane & 15) >> 2)) * 64;
    GLA_LAS bf16* OSB = (GLA_LAS bf16*)(lds + L_OS);
    const int NCH = seq / 64;
    GLA_DMA(0, 0);
    for (int n = 0; n <= NCH; ++n) {
        if (n <= 1) asm volatile("s_waitcnt vmcnt(0) lgkmcnt(0)\n\ts_barrier" ::: "memory");
        else asm volatile("s_waitcnt vmcnt(2) lgkmcnt(0)\n\ts_barrier" ::: "memory");
        const int set = n & 1;
        if (th == 0 || n >= NCH) { if (n + 1 < NCH) GLA_DMA(hot ? 0 : n + 1, set ^ 1); if (n < NCH) GLA_DMA_GATE(hot ? 0 : n, set); }
        GLA_LAS unsigned char* QD = lds + set * SET_BYTES + S_QD; GLA_LAS unsigned char* KI = lds + set * SET_BYTES + S_KI; GLA_LAS unsigned char* KE = lds + set * SET_BYTES + S_KE;
        GLA_LAS unsigned char* VT = lds + set * SET_BYTES + S_VT; GLA_LAS float* DEC = (GLA_LAS float*)(lds + set * SET_BYTES + S_DEC);
#pragma unroll
        for (int half = 0; half < 2; ++half) {
            const bool do5 = (half == 0) ? (th == 0) : (th != 0);
            if (do5) {
                if (n >= 1) {
                    const GLA_LAS bf16* osr = OSB + ((n - 1) & 1) * 8192 + tok * 128 + sub * 16;
                    const u32x4 oa = *(const GLA_LAS u32x4*)(osr), ob = *(const GLA_LAS u32x4*)(osr + 8);
                    float o[16]; unpack8(oa, o); unpack8(ob, o + 8);
                    float sq = 0.f;
#pragma unroll
                    for (int j = 0; j < 16; ++j) sq += o[j] * o[j];
                    sq += __shfl_xor(sq, 1); sq += __shfl_xor(sq, 2); sq += __shfl_xor(sq, 4);
                    const float rr = __builtin_amdgcn_rsqf(sq * (1.0f / 128.0f) + 1e-6f);
                    const GLA_LAS bf16* gtr = (const GLA_LAS bf16*)(lds + L_GT) + ((n - 1) & 1) * 8192 + tok * 128 + sub * 16;
                    const u32x4 gp0 = *(const GLA_LAS u32x4*)(gtr), gp1 = *(const GLA_LAS u32x4*)(gtr + 8);
                    float gv[16]; unpack8(gp0, gv); unpack8(gp1, gv + 8);
                    float r8[16];
#pragma unroll
                    for (int i = 0; i < 16; ++i) { const float gt = gv[i]; r8[i] = o[i] * rr * GN[sub * 16 + i] * (gt * __builtin_amdgcn_rcpf(1.0f + __builtin_amdgcn_exp2f(-gt * LOG2E))); }
                    bf16* orow = MIX + ((size_t)b * seq + (n - 1) * 64 + tok) * opitch + h * 128 + sub * 16;
                    *(GLA_GAS u32x4*)(orow) = (u32x4){cvtpk(r8[0], r8[1]), cvtpk(r8[2], r8[3]), cvtpk(r8[4], r8[5]), cvtpk(r8[6], r8[7])};
                    *(GLA_GAS u32x4*)(orow + 8) = (u32x4){cvtpk(r8[8], r8[9]), cvtpk(r8[10], r8[11]), cvtpk(r8[12], r8[13]), cvtpk(r8[14], r8[15])};
                }
            } else if (n < NCH) {
                const int qrow = 32 * th + r32;
                bf16x8 qb_[4], ka[4], kb[4], vf[4], af[4];
#pragma unroll
                for (int s = 0; s < 4; ++s) { qb_[s] = *(const GLA_LAS bf16x8*)(QD + (2 * s + hi) * 1024 + qrow * 16); ka[s] = *(const GLA_LAS bf16x8*)(KE + (s >> 1) * 4096 + r32 * 64 + (16 * (s & 1) + 8 * hi) * 2);
                    kb[s] = *(const GLA_LAS bf16x8*)(KE + (s >> 1) * 4096 + (32 + r32) * 64 + (16 * (s & 1) + 8 * hi) * 2); }
#pragma unroll
                for (int ks = 0; ks < 4; ++ks) { const s16x4 lo = trd(VT + c * 4096 + ks * 1024 + trl), hh = trd(VT + c * 4096 + ks * 1024 + 512 + trl);
                    vf[ks] = (bf16x8){lo[0], lo[1], lo[2], lo[3], hh[0], hh[1], hh[2], hh[3]}; }
#pragma unroll
                for (int s = 0; s < 4; ++s) { const s16x4 a0 = *(const GLA_LAS s16x4*)(QD + (2 * s) * 1024 + qrow * 16 + 8 * hi), a1 = *(const GLA_LAS s16x4*)(QD + (2 * s + 1) * 1024 + qrow * 16 + 8 * hi);
                    af[s] = (bf16x8){a0[0], a0[1], a0[2], a0[3], a1[0], a1[1], a1[2], a1[3]}; }
                GLA_SCHED();
                f32x16 X0 = {}, X1 = {};
                if (th) {
#pragma unroll
                    for (int s = 0; s < 4; ++s) { X0 = __builtin_amdgcn_mfma_f32_32x32x16_bf16(ka[s], qb_[s], X0, 0, 0, 0); X1 = __builtin_amdgcn_mfma_f32_32x32x16_bf16(kb[s], qb_[s], X1, 0, 0, 0); }
                } else {
#pragma unroll
                    for (int s = 0; s < 4; ++s) X0 = __builtin_amdgcn_mfma_f32_32x32x16_bf16(ka[s], qb_[s], X0, 0, 0, 0);
                }
                if (th != 0) { if (n + 1 < NCH) GLA_DMA(hot ? 0 : n + 1, set ^ 1); GLA_DMA_GATE(hot ? 0 : n, set); }
                f32x16 O2 = {};
#pragma unroll
                for (int s = 0; s < 4; ++s) { const bf16x8 bfr = (s < 2) ? pack8(S0, 8 * (s & 1)) : pack8(S1, 8 * (s & 1)); O2 = __builtin_amdgcn_mfma_f32_32x32x16_bf16(af[s], bfr, O2, 0, 0, 0); }
                GLA_SCHED();
                bf16x8 kt0[4], kt1[4];
#pragma unroll
                for (int ks = 0; ks < 4; ++ks) {
                    { const s16x4 lo = trd(KE + ks * 1024 + trl), hh = trd(KE + ks * 1024 + 512 + trl); kt0[ks] = (bf16x8){lo[0], lo[1], lo[2], lo[3], hh[0], hh[1], hh[2], hh[3]}; }
                    { const s16x4 lo = trd(KE + 4096 + ks * 1024 + trl), hh = trd(KE + 4096 + ks * 1024 + 512 + trl); kt1[ks] = (bf16x8){lo[0], lo[1], lo[2], lo[3], hh[0], hh[1], hh[2], hh[3]}; } }
                if (th) {
#pragma unroll
                    for (int r = 0; r < 16; ++r) if (crow(r, hi) > r32) X1[r] = 0.f;
                } else {
#pragma unroll
                    for (int r = 0; r < 16; ++r) if (crow(r, hi) > r32) X0[r] = 0.f;
                }
                f32x16 O = {};
                O = __builtin_amdgcn_mfma_f32_32x32x16_bf16(pack8(X0, 0), vf[0], O, 0, 0, 0);
                O = __builtin_amdgcn_mfma_f32_32x32x16_bf16(pack8(X0, 8), vf[1], O, 0, 0, 0);
                if (th) { O = __builtin_amdgcn_mfma_f32_32x32x16_bf16(pack8(X1, 0), vf[2], O, 0, 0, 0); O = __builtin_amdgcn_mfma_f32_32x32x16_bf16(pack8(X1, 8), vf[3], O, 0, 0, 0); }
#pragma unroll
                for (int ks = 0; ks < 4; ++ks) { S0 = __builtin_amdgcn_mfma_f32_32x32x16_bf16(kt0[ks], vf[ks], S0, 0, 0, 0); S1 = __builtin_amdgcn_mfma_f32_32x32x16_bf16(kt1[ks], vf[ks], S1, 0, 0, 0); }
#pragma unroll
                for (int g = 0; g < 4; ++g) { const f32x4 d0 = *(const GLA_LAS f32x4*)(DEC + 8 * g + 4 * hi), d1 = *(const GLA_LAS f32x4*)(DEC + 32 + 8 * g + 4 * hi);
#pragma unroll
                    for (int i = 0; i < 4; ++i) { S0[4 * g + i] *= d0[i]; S1[4 * g + i] *= d1[i]; } }
                { GLA_LAS bf16* osw = OSB + set * 8192 + 32 * th * 128 + 32 * c + r32;
#pragma unroll
                  for (int r = 0; r < 16; r += 2) { const unsigned w = cvtpk(O[r] + O2[r], O[r + 1] + O2[r + 1]); osw[crow(r, hi) * 128] = (bf16)(w & 0xffffu); osw[crow(r + 1, hi) * 128] = (bf16)(w >> 16); } }
            }
        }
    }
    asm volatile("s_waitcnt vmcnt(0) lgkmcnt(0)\n\ts_barrier" ::: "memory");
#undef GLA_DMA
#undef GLA_DMA_GATE
}
#undef GLA_LAS
#undef GLA_GAS
#undef GLA_BAR
#undef GLA_SCHED
}

struct Frame {
    LAS unsigned char* lds;
    volatile LAS unsigned* MISC;
    gu32* ctl;
    int tid, lane, wave;
    int vcu, G;
};

__device__ __forceinline__ float wave_sum(float v) {
#pragma unroll
    for (int o = 1; o < 64; o <<= 1) v += __shfl_xor(v, o);
    return v;
}
__device__ __forceinline__ float bf2f(unsigned short b) { return __builtin_bit_cast(float, (unsigned)b << 16); }
__device__ __forceinline__ float bflo(unsigned w) { return __builtin_bit_cast(float, w << 16); }
__device__ __forceinline__ float bfhi(unsigned w) { return __builtin_bit_cast(float, w & 0xffff0000u); }

__device__ __forceinline__ void tr_item(const float* W, int Nsrc, int sc, int nv, const float* gain, bf16* WT, int K, int drow0, int k0, LAS float* scr, int lane) {
    float tv[32];
#pragma unroll
    for (int i = 0; i < 32; ++i) { const int kk = 2 * i + (lane >> 5), n = lane & 31;
        tv[i] = (n < nv) ? W[(size_t)(k0 + kk) * Nsrc + sc + n] : 0.f; }
#pragma unroll
    for (int i = 0; i < 32; ++i) { const int kk = 2 * i + (lane >> 5), n = lane & 31;
        float v = tv[i]; if (gain) v *= gain[k0 + kk];
        scr[kk * 33 + n] = v; }
    LDS_WAIT(); asm volatile("" ::: "memory");
    const int c = lane & 7;
#pragma unroll
    for (int j = 0; j < 4; ++j) { const int n = (lane >> 3) + 8 * j; const LAS float* s = scr + (8 * c) * 33 + n;
        v4u o; o.x = pk2(s[0 * 33], s[1 * 33]); o.y = pk2(s[2 * 33], s[3 * 33]); o.z = pk2(s[4 * 33], s[5 * 33]); o.w = pk2(s[6 * 33], s[7 * 33]);
        *(GAS v4u*)(WT + (size_t)(drow0 + n) * K + k0 + 8 * c) = o; }
    LDS_WAIT(); asm volatile("" ::: "memory");
}
__device__ __forceinline__ void win_map(int db, int& sc, int& nv) {
    const int tile = db >> 3, r = db & 7, bj = r >> 2, wc = r & 3; nv = 32;
    if (tile < 6) sc = 32 * db;
    else if (tile < 8) sc = SRC_SQ + 256 * (tile - 6) + 64 * wc + 32 * bj;
    else if (tile < 10) sc = SRC_SK + 256 * (tile - 8) + 64 * wc + 32 * bj;
    else if (tile < 12) sc = SRC_SV + 32 * (db - 80);
    else if (db == 96) { sc = SRC_LR; nv = 16; }
    else { sc = 0; nv = 0; }
}
__device__ __forceinline__ void p0_prologue(Frame& F, const float* const* in, unsigned char* ws, int wmask  ) {
    LAS float* scr = (LAS float*)(F.lds + RING_OFF + F.wave * 16384);
    const int gw = F.vcu * NWAVES + F.wave, NGW = F.G * NWAVES;
    constexpr int I_W = 176 * 16, I_D = 32 * 44, I_IN = 104 * 16, I_O = 32 * 16;
    constexpr int NITEMS = 2 * I_W + 2 * I_D + I_IN + I_O;
    for (int it = gw; it < NITEMS; it += NGW) {
        int r = it;
        if (r < 2 * I_W) { const int second = r >= I_W; if (second) r -= I_W;
            if (!((wmask >> second) & 1)) continue;
            const int kb = r / 176, db = r % 176, tile = db >> 3, q = db & 7, bj = q >> 2, sub = q & 3;
            const float* W = in[second ? (bj ? 15 : 14) : (bj ? 3 : 2)];
            tr_item(W, DFF, 128 * tile + 32 * sub, 32, in[second ? 13 : 1], (bf16*)(ws + (second ? WS_W2 : WS_W1)), DM, 32 * db, 64 * kb, scr, F.lane); continue; }
        r -= 2 * I_W;
        if (r < 2 * I_D) { const int second = r >= I_D; if (second) r -= I_D;
            if (!((wmask >> second) & 1)) continue;
            const int kb = r / 32, db = r % 32;
            tr_item(in[second ? 16 : 4], DM, 32 * db, 32, nullptr, (bf16*)(ws + (second ? WS_WD2 : WS_WD1)), DFF, 32 * db, 64 * kb, scr, F.lane); continue; }
        r -= 2 * I_D;
        if (!(wmask & 1)) continue;
        if (r < I_IN) { const int kb = r / 104, db = r % 104; int sc, nv; win_map(db, sc, nv);
            tr_item(in[6], D_IN, sc, nv, in[5], (bf16*)(ws + WS_WIN), DM, 32 * db, 64 * kb, scr, F.lane); continue; }
        r -= I_IN;
        { const int kb = r / 32, db = r % 32;
            tr_item(in[12], DM, 32 * db, 32, nullptr, (bf16*)(ws + WS_WOUT), DM, 32 * db, 64 * kb, scr, F.lane); }
    }
    if (!(wmask & 1)) return;
    const float* x = in[0]; bf16* xb = (bf16*)(ws + WS_XB); float* ss0 = (float*)(ws + WS_SS0);
    for (int m0 = gw * 4; m0 < MROWS; m0 += NGW * 4) {
        f32x4 v[4][4];
#pragma unroll
        for (int r = 0; r < 4; ++r) { const GAS f32x4* xr = (const GAS f32x4*)(x + (size_t)(m0 + r) * DM) + F.lane;
#pragma unroll
            for (int j = 0; j < 4; ++j) v[r][j] = __builtin_nontemporal_load(xr + 64 * j); }
#pragma unroll
        for (int r = 0; r < 4; ++r) { float s = 0.f;
#pragma unroll
            for (int j = 0; j < 4; ++j) s += (v[r][j].x * v[r][j].x + v[r][j].y * v[r][j].y) + (v[r][j].z * v[r][j].z + v[r][j].w * v[r][j].w);
            s = wave_sum(s);
            GAS unsigned long long* o8 = (GAS unsigned long long*)(xb + (size_t)(m0 + r) * DM) + F.lane;
#pragma unroll
            for (int j = 0; j < 4; ++j) o8[64 * j] = (unsigned long long)pk2(v[r][j].x, v[r][j].y) | ((unsigned long long)pk2(v[r][j].z, v[r][j].w) << 32);
            if (F.lane == 0) ss0[m0 + r] = s; }
    }
}

#ifndef PROBE_HOT
#define PROBE_HOT 0
#endif
#ifndef REP4
#define REP4 1
#endif
#ifndef PROBE_MASK
#define PROBE_MASK 2
#endif
#ifndef SB_EXIT
#define SB_EXIT true
#endif
__device__ __forceinline__ void p4_mix(Frame& F, const float* const* in, unsigned char* ws, const float* out_scratch, unsigned char* lds_generic, int rep) {
    unsigned* ctr = (unsigned*)(F.ctl + CW_WORK + 64 * rep);
    for (;;) {
        if (F.tid == 0) F.MISC[0] = atomicAdd(ctr, 1u);
        __syncthreads();
        const unsigned u = F.MISC[0];
        __syncthreads();
        if (u >= 64u + 2048u) break;
        if (u < 64u) { if (rep == REP4 - 1 || (PROBE_MASK & 1)) gla::gla_unit((int)u >> 2, (int)u & 3, (const bf16*)(ws + WS_BIG), NPROJ, PC_GV, PC_GG, (const unsigned char*)out_scratch, (bf16*)(ws + WS_MIX), DM, SEQ, in[9], F.lds + RING_OFF, (const char*)lds_generic + RING_OFF, (PROBE_HOT && rep != REP4 - 1)); }
        else if (rep == REP4 - 1 || (PROBE_MASK & 2)) { const int a = (int)u - 64; const int bh = a & 127, qb = 15 - (a >> 7);
            sb::sb_unit<SB_EXIT>(bh >> 3, bh & 7, qb, (const bf16*)(ws + WS_BIG), NPROJ, PC_SQ, PC_SK, PC_SV, (bf16*)(ws + WS_MIX), DM, 512, SEQ, (char*)lds_generic + RING_OFF, F.lds + RING_OFF); }
    }
}

constexpr int N_PHASES = 9;
#ifndef MK_N_LAUNCHES
#define MK_N_LAUNCHES 1
#endif
struct Args { const float* in[17]; float* out; unsigned char* ws; int ph_lo, ph_hi; };
__global__ void __launch_bounds__(NWAVES * 64, 2) mk_fwd(Args args) {
    extern __shared__ __attribute__((aligned(16))) unsigned char lds[];
    Frame F;
    F.lds = (LAS unsigned char*)lds;
    F.MISC = (volatile LAS unsigned*)(F.lds + MISC_OFF);
    F.tid = threadIdx.x; F.lane = F.tid & 63; F.wave = __builtin_amdgcn_readfirstlane(F.tid >> 6);
    F.G = gridDim.x; { const int bx = blockIdx.x; F.vcu = (F.G % 8 == 0) ? (bx % 8) * (F.G / 8) + bx / 8 : bx; }
    unsigned char* ws = args.ws;
    F.ctl = (gu32*)(ws + WS_CTL);
    for (int u = F.tid; u < (LDS_BYTES - LDSCTL_OFF) / 4; u += NWAVES * 64) ((LAS unsigned*)(F.lds + LDSCTL_OFF))[u] = 0u;
    __syncthreads();
    XcdBarrier bar; bar.bar = (unsigned*)(F.ctl + CW_BAR); bar.x = 0; bar.st = nullptr;
    if (MK_N_LAUNCHES != N_PHASES) bar = xcd_barrier_post((unsigned*)(F.ctl + CW_BAR), F.MISC + 8);
    const int lo = args.ph_lo, hi = args.ph_hi;
#ifndef STAMP_PH
#define STAMP_PH -1
#endif
#ifndef STAMP_K
#define STAMP_K 4
#endif
    unsigned long long st_t0 = 0, st_dt = 0;
#define ST_BEGIN(k) do { if ((k) == STAMP_PH) st_t0 = __builtin_amdgcn_s_memrealtime(); } while (0)
#define ST_END(k) do { if ((k) == STAMP_PH) st_dt = __builtin_amdgcn_s_memrealtime() - st_t0; } while (0)
#define IN(k) (lo <= (k) && (k) < hi)
#define BOTH(k) (IN(k) && IN((k) + 1))
#define GRID_BAR() xcd_barrier(bar)
#ifndef STAGGER_TICKS
#define STAGGER_TICKS 0
#endif
#define STAGGER(ticks) do { if ((ticks) > 0) { const unsigned long long t0_ = __builtin_amdgcn_s_memrealtime(); const unsigned long long d_ = (unsigned long long)(((unsigned)blockIdx.x >> 3) & 7u) * (ticks) / 8; \
        while (__builtin_amdgcn_s_memrealtime() - t0_ < d_) __builtin_amdgcn_s_sleep(4); } } while (0)
    bf16* XB = (bf16*)(ws + WS_XB); bf16* MIX = (bf16*)(ws + WS_MIX); bf16* BIG = (bf16*)(ws + WS_BIG);
    float* SS0 = (float*)(ws + WS_SS0); float* SS1 = (float*)(ws + WS_SS1); float* SS2 = (float*)(ws + WS_SS2);
    const float* x = args.in[0]; float* out = args.out;

    ST_BEGIN(0);
    #ifndef W2_LATE
#define W2_LATE 1
#endif
    if (IN(0)) { p0_prologue(F, args.in, ws, W2_LATE ? 1 : 3); if (BOTH(0)) GRID_BAR(); }
#ifndef PROBE1
#define PROBE1 0
#endif
    if (PROBE1 && IN(1)) {
        pg8::Gemm g{XB, (const bf16*)(ws + WS_W1), MROWS, 2 * DFF, DM}; pg8::StaticOrder S; S.init(MROWS, 2 * DFF, F.G, (int)blockIdx.x);
        pg8::EpiSwiGLU<PROBE1> E{BIG, DFF, SS0};
        pg8::gemm_phase<pg8::EpiSwiGLU<PROBE1>, pg8::StaticOrder, true, true>(F.lds + RING_OFF, g, S, E);
        GRID_BAR();
    }
    ST_END(0);
    ST_BEGIN(1);
    if (IN(1)) {
        pg8::Gemm g{XB, (const bf16*)(ws + WS_W1), MROWS, 2 * DFF, DM}; pg8::StaticOrder S; S.init(MROWS, 2 * DFF, F.G, (int)blockIdx.x);
        pg8::EpiSwiGLU<0> E{BIG, DFF, SS0};
        pg8::gemm_phase<pg8::EpiSwiGLU<0>, pg8::StaticOrder, true, true>(F.lds + RING_OFF, g, S, E);
        if (BOTH(1)) GRID_BAR();
    }
    ST_END(1);
    ST_BEGIN(2);
    if (IN(2)) {
        pg8::Gemm g{BIG, (const bf16*)(ws + WS_WD1), MROWS, DM, DFF}; pg8::StaticOrder S; S.init(MROWS, DM, F.G, (int)blockIdx.x);
        pg8::EpiRes E{XB, nullptr, 0.5f, SS1, 1};
        pg8::gemm_phase<pg8::EpiRes, pg8::StaticOrder, true, true>(F.lds + RING_OFF, g, S, E);
        if (BOTH(2)) GRID_BAR();
    }
    ST_END(2);
    ST_BEGIN(3);
    if (IN(3)) {
        STAGGER(STAGGER_TICKS);
        pg8::Gemm g{XB, (const bf16*)(ws + WS_WIN), MROWS, NPROJ, DM}; pg8::StaticOrder S; S.init(MROWS, NPROJ, F.G, (int)blockIdx.x);
        pg8::EpiProj E{BIG, NPROJ, SS1, args.in[10], args.in[11], SBQ_SCALE};
        pg8::gemm_phase<pg8::EpiProj, pg8::StaticOrder, true, true>(F.lds + RING_OFF, g, S, E);
        if (BOTH(3)) GRID_BAR();
    }
    #ifndef REP4
#define REP4 1
#endif
    ST_END(3);
    ST_BEGIN(4);
    if (IN(4)) {
        { constexpr int NU = BATCH * GLA_H * (SEQ / 256); gla::PrepLoads cur, nxt; int u = (int)blockIdx.x;
          if (u < NU) gla::prep_load(cur, u, (const bf16*)(ws + WS_BIG), NPROJ, PC_GQ, PC_GK, PC_LR, SEQ);
          for (; u < NU; u += F.G) {
              const bool more = (u + F.G < NU);
              if (more) gla::prep_load(nxt, u + F.G, (const bf16*)(ws + WS_BIG), NPROJ, PC_GQ, PC_GK, PC_LR, SEQ);
              gla::prep_unit(cur, u, (unsigned char*)args.out, args.in[7], args.in[8], F.lds + RING_OFF);
              if (more) cur = nxt; } }
        if (BOTH(4)) GRID_BAR();
    }
    ST_END(4);
    ST_BEGIN(5);
    if (IN(5)) { for (int rep = 0; rep < REP4; ++rep) { p4_mix(F, args.in, ws, args.out, lds, rep); if (BOTH(5)) GRID_BAR(); } }
    ST_END(5);
    ST_BEGIN(6);
    if (IN(6)) {
        pg8::Gemm g{MIX, (const bf16*)(ws + WS_WOUT), MROWS, DM, DM}; pg8::StaticOrder S; S.init(MROWS, DM, F.G, (int)blockIdx.x);
        pg8::EpiRes E{XB, nullptr, 1.0f, SS2, 1};
        pg8::gemm_phase<pg8::EpiRes, pg8::StaticOrder, true, true>(F.lds + RING_OFF, g, S, E);
        if (BOTH(6)) GRID_BAR();
    }
    ST_END(6);
    ST_BEGIN(7);
    if (IN(7)) {
        if (W2_LATE) { p0_prologue(F, args.in, ws, 2); GRID_BAR(); }
        pg8::Gemm g{XB, (const bf16*)(ws + WS_W2), MROWS, 2 * DFF, DM}; pg8::StaticOrder S; S.init(MROWS, 2 * DFF, F.G, (int)blockIdx.x);
        pg8::EpiSwiGLU<0> E{BIG, DFF, SS2};
        pg8::gemm_phase<pg8::EpiSwiGLU<0>, pg8::StaticOrder, true, true>(F.lds + RING_OFF, g, S, E);
        if (BOTH(7)) GRID_BAR();
    }
    ST_END(7);
    ST_BEGIN(8);
    if (IN(8)) {
        pg8::Gemm g{BIG, (const bf16*)(ws + WS_WD2), MROWS, DM, DFF}; pg8::StaticOrder S; S.init(MROWS, DM, F.G, (int)blockIdx.x);
        pg8::EpiRes E{XB, out, 0.5f, nullptr, 0};
        pg8::gemm_phase<pg8::EpiRes, pg8::StaticOrder, true, true>(F.lds + RING_OFF, g, S, E);
    }
    ST_END(8);
    if (STAMP_PH >= 0 && blockIdx.x == 0 && F.tid == 0) { const unsigned long long te = __builtin_amdgcn_s_memrealtime(); while (__builtin_amdgcn_s_memrealtime() - te < (unsigned long long)STAMP_K * st_dt) __builtin_amdgcn_s_sleep(8); }
#undef IN
#undef BOTH
#undef GRID_BAR
}

extern "C" void kernel_launch(void* const* d_in, const int* in_sizes, int n_in, void* d_out, int out_size, void* d_ws, size_t ws_size, hipStream_t stream) {
    static int grid = 0;
    if (grid == 0) {
        if (n_in != 17 || in_sizes[0] != MROWS * DM || out_size != MROWS * DM || ws_size < WS_END) {
            fprintf(stderr, "kernel_launch: unexpected shapes: n_in %d in0 %d out %d ws %zu (need %zu)\n", n_in, n_in > 0 ? in_sizes[0] : -1, out_size, ws_size, (size_t)WS_END); grid = -1; return; }
        int dev = 0, cus = 0, per_cu = 0;
        if (hipGetDevice(&dev) != hipSuccess || hipDeviceGetAttribute(&cus, hipDeviceAttributeMultiprocessorCount, dev) != hipSuccess) { grid = -1; return; }
        if (hipFuncSetAttribute((const void*)mk_fwd, hipFuncAttributeMaxDynamicSharedMemorySize, LDS_BYTES) != hipSuccess) { fprintf(stderr, "kernel_launch: hipFuncSetAttribute failed\n"); grid = -1; return; }
        if (hipOccupancyMaxActiveBlocksPerMultiprocessor(&per_cu, (const void*)mk_fwd, NWAVES * 64, LDS_BYTES) != hipSuccess || per_cu < 1)
            fprintf(stderr, "kernel_launch: occupancy query reports %d workgroups per CU\n", per_cu);
        (void)hipGetLastError();
        grid = cus;
    }
    if (grid < 0) return;
    if (hipMemsetAsync((char*)d_ws + WS_CTL, 0, CTL_ZERO_BYTES, stream) != hipSuccess) { fprintf(stderr, "kernel_launch: memset failed\n"); return; }
    Args a{};
    for (int i = 0; i < 17; ++i) a.in[i] = (const float*)d_in[i];
    a.out = (float*)d_out; a.ws = (unsigned char*)d_ws;
    for (int li = 0; li < MK_N_LAUNCHES; ++li) {
        if (MK_N_LAUNCHES == N_PHASES) { a.ph_lo = li; a.ph_hi = li + 1; } else { a.ph_lo = 0; a.ph_hi = N_PHASES; }
        hipLaunchKernelGGL(mk_fwd, dim3(grid), dim3(NWAVES * 64), LDS_BYTES, stream, a);
        const hipError_t le = hipPeekAtLastError();
        if (le != hipSuccess) { fprintf(stderr, "kernel_launch: launch %d failed: %s\n", li, hipGetErrorName(le)); break; }
    }
}
```

```cpp
#include <hip/hip_runtime.h>
#include <cstdio>
#include <cstdint>
#include <cmath>
#include <type_traits>
namespace pg8 {
#define PG8_LAS __attribute__((address_space(3)))
typedef unsigned short bf16_t;
typedef short bf16x8 __attribute__((ext_vector_type(8)));
typedef float f32x4 __attribute__((ext_vector_type(4)));
typedef unsigned u32x4 __attribute__((ext_vector_type(4)));
constexpr int BM = 256, BK = 64, HALF = 128, HTB = HALF * BK * 2  , STAGE_BYTES = 8 * HTB, NXCD = 8, WGM = 8;

__host__ __device__ __forceinline__ int lds_byte(int r, int c) { const int st = (r >> 4) * 2 + (c >> 5), rr = r & 15, cc = c & 31, ob = rr * 64 + cc * 2; return st * 1024 + (ob ^ (((ob >> 9) & 1) << 5)); }
__host__ __device__ __forceinline__ void stage_rc(int b, int& R, int& C) { const int st = b / 1024, sb = b % 1024, swz = sb ^ (((sb >> 9) & 1) << 5); R = (st >> 1) * 16 + swz / 64; C = (st & 1) * 32 + (swz % 64) / 2; }
__host__ __device__ __forceinline__ int perm32(int rho) { const int n = rho >> 4, i = rho & 15; return 8 * (i >> 2) + 4 * n + (i & 3); }

struct Unit { int pm, pn; };
struct Gemm { const bf16_t* A; const bf16_t* Bt; int M, N, K, lda, ldb; };

struct StaticOrder {
    int nM, nN, nwg, G, c;
    __host__ __device__ void init(int M, int N, int G_, int c_) { nM = M / BM; nN = N / BM; nwg = nM * nN; G = G_; c = c_; }
    __host__ __device__ bool next(int i, Unit& u) const {
        const long L = (long)i * G + c; if (L >= nwg) return false;
        int wgid = (int)L; { const int q = nwg / NXCD, r = nwg % NXCD, xcd = wgid % NXCD, off = wgid / NXCD; wgid = (xcd < r ? xcd * (q + 1) : r * (q + 1) + (xcd - r) * q) + off; }
        const int nig = WGM * nN, gid = wgid / nig, fm = gid * WGM, gsz = (nM - fm) < WGM ? (nM - fm) : WGM;
        u.pm = fm + ((wgid % nig) % gsz); u.pn = (wgid % nig) / gsz; return true;
    }
    __device__ __forceinline__ void a_ready(const Unit&) const {}
    __device__ __forceinline__ void done(const Unit&) const {}
};

struct SameOrder {
    StaticOrder o;
    __host__ __device__ void init(int M, int N, int G_, int c_) { o.init(M, N, G_, c_); }
    __host__ __device__ bool next(int i, Unit& u) const { const bool r = o.next(i, u); u.pm = o.c & 7; u.pn = 0; return r; }
    __device__ __forceinline__ void a_ready(const Unit&) const {}
    __device__ __forceinline__ void done(const Unit&) const {}
};

__device__ __forceinline__ unsigned cvt_pk_bf16(float lo, float hi) { unsigned r; asm volatile("v_cvt_pk_bf16_f32 %0, %1, %2" : "=v"(r) : "v"(lo), "v"(hi)); return r; }
typedef float f32x2 __attribute__((ext_vector_type(2)));
constexpr float NORM_EPS = 1e-6f;
constexpr float LOG2E = 1.4426950408889634f;
__device__ __forceinline__ float silu_f(float g) { return g * __builtin_amdgcn_rcpf(1.0f + __builtin_amdgcn_exp2f(-g * LOG2E)); }
__device__ __forceinline__ float row_rs(const float* ss, int row, float inv_n) { return __builtin_amdgcn_rsqf(ss[row] * inv_n + NORM_EPS); }

template <int MODE = 0  > struct EpiSwiGLU {
    static constexpr bool PERM = true, STAGED = (MODE == 0), AFTER_DRAIN = false, EXT = false;
    bf16_t* O; int ldo; const float* ss;
    static constexpr bool PROBE_NOZERO = (MODE == 4);
    static constexpr bool PRE = true;
    __device__ __forceinline__ void preload(float (&ssv)[2][4], const Unit& u, int wr, int fr) const {
        const int row0 = u.pm * BM + wr * 64 + fr;
#pragma unroll
        for (int ai = 0; ai < 2; ++ai)
#pragma unroll
            for (int m = 0; m < 4; ++m) asm volatile("global_load_dword %0, %1, off" : "=v"(ssv[ai][m]) : "v"(ss + row0 + ai * HALF + m * 16) : "memory");
    }
    __device__ __forceinline__ void operator()(const f32x4 (&acc)[2][2][4][2], const Unit& u, int wr, int wc, int fr, int fq, const float (&ssv)[2][4], PG8_LAS unsigned char* sb = nullptr) const {
        if (MODE == 2) return;
        const int row0 = u.pm * BM + wr * 64 + fr, col0 = u.pn * HALF + wc * 32 + 8 * fq;
        if (MODE == 4) {
            f32x4 t = {0.f, 0.f, 0.f, 0.f};
#pragma unroll
            for (int ai = 0; ai < 2; ++ai)
#pragma unroll
                for (int bj = 0; bj < 2; ++bj)
#pragma unroll
                    for (int m = 0; m < 4; ++m) { t += acc[ai][bj][m][0]; t += acc[ai][bj][m][1]; }
            const float q = (t[0] + t[1]) + (t[2] + t[3]) + ((ssv[0][0] + ssv[0][1]) + (ssv[0][2] + ssv[0][3])) + ((ssv[1][0] + ssv[1][1]) + (ssv[1][2] + ssv[1][3]));
            if (__builtin_bit_cast(unsigned, q) == 0x7fc1abcdu) O[(size_t)row0 * ldo + col0] = 1;
            return;
        }
#pragma unroll
        for (int ai = 0; ai < 2; ++ai)
#pragma unroll
            for (int m = 0; m < 4; ++m) {
                const int row = row0 + ai * HALF + m * 16;
                const float ir2 = ssv[ai][m] * (1.0f / 1024.0f) + NORM_EPS;
                const float r = __builtin_amdgcn_rsqf(ir2);
                const float rl = -r * LOG2E;
                float a[8];
#pragma unroll
                for (int n = 0; n < 2; ++n) {
                    const f32x4 gg = acc[ai][0][m][n], uu = acc[ai][1][m][n];
                    const f32x4 e = gg * rl;
                    f32x4 d; d[0] = __builtin_amdgcn_exp2f(e[0]); d[1] = __builtin_amdgcn_exp2f(e[1]); d[2] = __builtin_amdgcn_exp2f(e[2]); d[3] = __builtin_amdgcn_exp2f(e[3]);
                    d = d * ir2 + ir2;
                    f32x4 inv; inv[0] = __builtin_amdgcn_rcpf(d[0]); inv[1] = __builtin_amdgcn_rcpf(d[1]); inv[2] = __builtin_amdgcn_rcpf(d[2]); inv[3] = __builtin_amdgcn_rcpf(d[3]);
                    const f32x4 o4 = (gg * uu) * inv;
                    a[4 * n + 0] = o4[0]; a[4 * n + 1] = o4[1]; a[4 * n + 2] = o4[2]; a[4 * n + 3] = o4[3];
                }
                u32x4 w; w.x = cvt_pk_bf16(a[0], a[1]); w.y = cvt_pk_bf16(a[2], a[3]); w.z = cvt_pk_bf16(a[4], a[5]); w.w = cvt_pk_bf16(a[6], a[7]);
                if (MODE == 0) {
                    const int lane = fr + 16 * fq;
                    *(PG8_LAS u32x4*)(sb + fr * 80 + fq * 16) = w;
                    const u32x4 sv = *(const PG8_LAS u32x4*)(sb + (lane >> 2) * 80 + (lane & 3) * 16);
                    *(u32x4*)(O + (size_t)(u.pm * BM + wr * 64 + ai * HALF + m * 16 + (lane >> 2)) * ldo + u.pn * HALF + wc * 32 + (lane & 3) * 8) = sv; }
                else if (MODE == 3) *(u32x4*)(O + (size_t)(row & 255) * ldo + col0) = w; else if (w.x == 0x7fc1abcdu) *(u32x4*)(O + (size_t)row * ldo + col0) = w;
            }
    }
};

constexpr int XPITCH = 1088;
struct EpiResS {
    static constexpr bool PERM = true, PERM2 = true, STAGED = true, AFTER_DRAIN = false, EXT = false, PRE = false, PROBE_NOZERO = false;
    bf16_t* xb; float alpha; float* ssq;
    __device__ __forceinline__ void operator()(const f32x4 (&acc)[2][2][4][2], const Unit& u, int wr, int wc, int fr, int fq, PG8_LAS unsigned char* sb) const {
        const int rowb = u.pm * BM + wr * 64, lane = fr + 16 * fq;
        PG8_LAS unsigned char* lnptr = sb + fr * 144 + fq * 16;
        PG8_LAS unsigned char* gptr = sb + (lane >> 3) * 144 + (lane & 7) * 16;
        bf16_t* sptr = xb + (size_t)(rowb + (lane >> 3)) * XPITCH + u.pn * BM + wc * 64 + (lane & 7) * 8;
#pragma unroll
        for (int ai = 0; ai < 2; ++ai) {
            u32x4 g[4][2];
#pragma unroll
            for (int m = 0; m < 4; ++m)
#pragma unroll
                for (int h = 0; h < 2; ++h) g[m][h] = *(const u32x4*)(sptr + (size_t)(ai * HALF + m * 16 + 8 * h) * XPITCH);
#pragma unroll
            for (int m = 0; m < 4; ++m) {
                const int row = rowb + fr + ai * HALF + m * 16;
                *(PG8_LAS u32x4*)(gptr) = g[m][0]; *(PG8_LAS u32x4*)(gptr + 8 * 144) = g[m][1];
                float sq = 0.f;
#pragma unroll
                for (int bj = 0; bj < 2; ++bj) {
                    const u32x4 b_ = *(const PG8_LAS u32x4*)(lnptr + bj * 64);
                    f32x4 b0, b1;
                    b0[0] = __builtin_bit_cast(float, b_.x << 16); b0[1] = __builtin_bit_cast(float, b_.x & 0xffff0000u); b0[2] = __builtin_bit_cast(float, b_.y << 16); b0[3] = __builtin_bit_cast(float, b_.y & 0xffff0000u);
                    b1[0] = __builtin_bit_cast(float, b_.z << 16); b1[1] = __builtin_bit_cast(float, b_.z & 0xffff0000u); b1[2] = __builtin_bit_cast(float, b_.w << 16); b1[3] = __builtin_bit_cast(float, b_.w & 0xffff0000u);
                    const f32x4 o0 = b0 + acc[ai][bj][m][0] * alpha, o1 = b1 + acc[ai][bj][m][1] * alpha;
                    u32x4 w; w.x = cvt_pk_bf16(o0[0], o0[1]); w.y = cvt_pk_bf16(o0[2], o0[3]); w.z = cvt_pk_bf16(o1[0], o1[1]); w.w = cvt_pk_bf16(o1[2], o1[3]);
                    *(PG8_LAS u32x4*)(lnptr + bj * 64) = w;
                    sq += (o0[0] * o0[0] + o0[1] * o0[1]) + (o0[2] * o0[2] + o0[3] * o0[3]) + (o1[0] * o1[0] + o1[1] * o1[1]) + (o1[2] * o1[2] + o1[3] * o1[3]);
                }
                const u32x4 s0 = *(const PG8_LAS u32x4*)(gptr), s1 = *(const PG8_LAS u32x4*)(gptr + 8 * 144);
                bf16_t* sp = sptr + (size_t)(ai * HALF + m * 16) * XPITCH;
                *(u32x4*)(sp) = s0; *(u32x4*)(sp + (size_t)8 * XPITCH) = s1;
                sq += __shfl_xor(sq, 16); sq += __shfl_xor(sq, 32); if (fq == 0) atomicAdd(ssq + row, sq);
            }
            asm volatile("" ::: "memory");
        }
    }
};

struct EpiRes {
    static constexpr bool PERM = true, AFTER_DRAIN = false, EXT = false, PRE = false, PROBE_NOZERO = false;
    bf16_t* xb; float* outf; float alpha; float* ssq; int wr_xb;
    __device__ __forceinline__ void operator()(const f32x4 (&acc)[2][2][4][2], const Unit& u, int wr, int wc, int fr, int fq) const {
        const int row0 = u.pm * BM + wr * 64 + fr, col0 = u.pn * BM + wc * 32 + 8 * fq;
#pragma unroll
        for (int ai = 0; ai < 2; ++ai) {
            u32x4 bw[4][2];
#pragma unroll
            for (int m = 0; m < 4; ++m)
#pragma unroll
                for (int bj = 0; bj < 2; ++bj) bw[m][bj] = *(const u32x4*)(xb + (size_t)(row0 + ai * HALF + m * 16) * XPITCH + col0 + bj * HALF);
#pragma unroll
            for (int m = 0; m < 4; ++m) {
                const int row = row0 + ai * HALF + m * 16;
                const size_t off = (size_t)row * 1024 + col0, offx = (size_t)row * XPITCH + col0;
                float sq = 0.f;
#pragma unroll
                for (int bj = 0; bj < 2; ++bj) {
                    const u32x4 b_ = bw[m][bj];
                    f32x4 b0, b1;
                    b0[0] = __builtin_bit_cast(float, b_.x << 16); b0[1] = __builtin_bit_cast(float, b_.x & 0xffff0000u); b0[2] = __builtin_bit_cast(float, b_.y << 16); b0[3] = __builtin_bit_cast(float, b_.y & 0xffff0000u);
                    b1[0] = __builtin_bit_cast(float, b_.z << 16); b1[1] = __builtin_bit_cast(float, b_.z & 0xffff0000u); b1[2] = __builtin_bit_cast(float, b_.w << 16); b1[3] = __builtin_bit_cast(float, b_.w & 0xffff0000u);
                    const f32x4 o0 = b0 + acc[ai][bj][m][0] * alpha, o1 = b1 + acc[ai][bj][m][1] * alpha;
                    if (outf) { *(f32x4*)(outf + off + bj * HALF) = o0; *(f32x4*)(outf + off + bj * HALF + 4) = o1; }
                    if (wr_xb) { u32x4 w; w.x = cvt_pk_bf16(o0[0], o0[1]); w.y = cvt_pk_bf16(o0[2], o0[3]); w.z = cvt_pk_bf16(o1[0], o1[1]); w.w = cvt_pk_bf16(o1[2], o1[3]);
                        *(u32x4*)(xb + offx + bj * HALF) = w; }
                    sq += (o0[0] * o0[0] + o0[1] * o0[1]) + (o0[2] * o0[2] + o0[3] * o0[3]) + (o1[0] * o1[0] + o1[1] * o1[1]) + (o1[2] * o1[2] + o1[3] * o1[3]);
                }
                if (ssq) { sq += __shfl_xor(sq, 16); sq += __shfl_xor(sq, 32); if (fq == 0) atomicAdd(ssq + row, sq); }
            }
            asm volatile("" ::: "memory");
        }
    }
};

struct EpiResOut {
    static constexpr bool PERM = false, AFTER_DRAIN = false, EXT = false, PRE = false, PROBE_NOZERO = false;
    const bf16_t* xb; float* outf; float alpha;
    __device__ __forceinline__ void operator()(const f32x4 (&acc)[2][2][4][2], const Unit& u, int wr, int wc, int fr, int fq) const {
        typedef unsigned u32x2 __attribute__((ext_vector_type(2)));
        const int row0 = u.pm * BM + wr * 64 + fr, col0 = u.pn * BM + wc * 32 + 4 * fq;
#pragma unroll
        for (int ai = 0; ai < 2; ++ai) {
            u32x2 bw[4][2][2];
#pragma unroll
            for (int m = 0; m < 4; ++m)
#pragma unroll
                for (int bj = 0; bj < 2; ++bj)
#pragma unroll
                    for (int n = 0; n < 2; ++n) bw[m][bj][n] = *(const u32x2*)(xb + (size_t)(row0 + ai * HALF + m * 16) * XPITCH + col0 + bj * HALF + n * 16);
#pragma unroll
            for (int m = 0; m < 4; ++m) {
                const size_t off = (size_t)(row0 + ai * HALF + m * 16) * 1024 + col0;
#pragma unroll
                for (int bj = 0; bj < 2; ++bj)
#pragma unroll
                    for (int n = 0; n < 2; ++n) { const u32x2 b_ = bw[m][bj][n]; f32x4 b4;
                        b4[0] = __builtin_bit_cast(float, b_.x << 16); b4[1] = __builtin_bit_cast(float, b_.x & 0xffff0000u); b4[2] = __builtin_bit_cast(float, b_.y << 16); b4[3] = __builtin_bit_cast(float, b_.y & 0xffff0000u);
                        *(f32x4*)(outf + off + bj * HALF + n * 16) = b4 + acc[ai][bj][m][n] * alpha; }
            }
            asm volatile("" ::: "memory");
        }
    }
};

struct EpiResOutS {
    static constexpr bool PERM = false, PERM2 = true, STAGED = true, AFTER_DRAIN = false, EXT = false, PRE = false, PROBE_NOZERO = false;
    const bf16_t* xb; float* outf; float alpha;
    __device__ __forceinline__ void operator()(const f32x4 (&acc)[2][2][4][2], const Unit& u, int wr, int wc, int fr, int fq, PG8_LAS unsigned char* sb) const {
        typedef unsigned u32x2 __attribute__((ext_vector_type(2)));
        const int rowb = u.pm * BM + wr * 64, lane = fr + 16 * fq;
        PG8_LAS unsigned char* wptr = sb + (lane >> 3) * 144 + (lane & 7) * 16;
        const PG8_LAS unsigned char* rptr = sb + fr * 144 + fq * 8;
        const bf16_t* lptr = xb + (size_t)(rowb + (lane >> 3)) * XPITCH + u.pn * BM + wc * 64 + (lane & 7) * 8;
        PG8_LAS unsigned char* fptr = sb + fr * 144 + fq * 16;
        float* ogp = outf + (size_t)(rowb + (lane >> 3)) * 1024 + u.pn * BM + wc * 64 + (lane & 7) * 4;
#pragma unroll
        for (int ai = 0; ai < 2; ++ai) {
            u32x4 g[4][2];
#pragma unroll
            for (int m = 0; m < 4; ++m)
#pragma unroll
                for (int h = 0; h < 2; ++h) g[m][h] = *(const u32x4*)(lptr + (size_t)(ai * HALF + m * 16 + 8 * h) * XPITCH);
#pragma unroll
            for (int m = 0; m < 4; ++m) {
                *(PG8_LAS u32x4*)(wptr) = g[m][0]; *(PG8_LAS u32x4*)(wptr + 8 * 144) = g[m][1];
                float* op = ogp + (size_t)(ai * HALF + m * 16) * 1024;
                f32x4 o[2][2];
#pragma unroll
                for (int bj = 0; bj < 2; ++bj)
#pragma unroll
                    for (int n = 0; n < 2; ++n) { const u32x2 b_ = *(const PG8_LAS u32x2*)(rptr + bj * 64 + n * 32); f32x4 b4;
                        b4[0] = __builtin_bit_cast(float, b_.x << 16); b4[1] = __builtin_bit_cast(float, b_.x & 0xffff0000u); b4[2] = __builtin_bit_cast(float, b_.y << 16); b4[3] = __builtin_bit_cast(float, b_.y & 0xffff0000u);
                        o[bj][n] = b4 + acc[ai][bj][m][n] * alpha; }
#pragma unroll
                for (int bj = 0; bj < 2; ++bj) {
                    *(PG8_LAS f32x4*)(fptr) = o[bj][0]; *(PG8_LAS f32x4*)(fptr + 64) = o[bj][1];
                    const f32x4 s0 = *(const PG8_LAS f32x4*)(wptr), s1 = *(const PG8_LAS f32x4*)(wptr + 8 * 144);
                    *(f32x4*)(op + bj * 32) = s0; *(f32x4*)(op + bj * 32 + (size_t)8 * 1024) = s1; }
            }
            asm volatile("" ::: "memory");
        }
    }
};

template <int ALPHA_NUM, int ALPHA_DEN>
struct EpiResX {
    static constexpr bool PERM = true, AFTER_DRAIN = false, EXT = true, PRE = false, PROBE_NOZERO = false;
    static constexpr float alpha = (float)ALPHA_NUM / (float)ALPHA_DEN;
    bf16_t* xb; const bf16_t* ident; float* ssq;
    __device__ __forceinline__ const bf16_t* ext_a() const { return xb; }
    __device__ __forceinline__ const bf16_t* ext_b() const { return ident; }
    __device__ __forceinline__ void operator()(const f32x4 (&acc)[2][2][4][2], const Unit& u, int wr, int wc, int fr, int fq) const {
        const int row0 = u.pm * BM + wr * 64 + fr, col0 = u.pn * BM + wc * 32 + 8 * fq;
#pragma unroll
        for (int ai = 0; ai < 2; ++ai) {
#pragma unroll
            for (int m = 0; m < 4; ++m) {
                const int row = row0 + ai * HALF + m * 16;
                const size_t off = (size_t)row * 1024 + col0;
                float sq = 0.f;
#pragma unroll
                for (int bj = 0; bj < 2; ++bj) {
                    const f32x4 o0 = acc[ai][bj][m][0] * alpha, o1 = acc[ai][bj][m][1] * alpha;
                    u32x4 w; w.x = cvt_pk_bf16(o0[0], o0[1]); w.y = cvt_pk_bf16(o0[2], o0[3]); w.z = cvt_pk_bf16(o1[0], o1[1]); w.w = cvt_pk_bf16(o1[2], o1[3]);
                    *(u32x4*)(xb + off + bj * HALF) = w;
                    sq += (o0[0] * o0[0] + o0[1] * o0[1]) + (o0[2] * o0[2] + o0[3] * o0[3]) + (o1[0] * o1[0] + o1[1] * o1[1]) + (o1[2] * o1[2] + o1[3] * o1[3]);
                }
                sq += __shfl_xor(sq, 16); sq += __shfl_xor(sq, 32); if (fq == 0) atomicAdd(ssq + row, sq);
            }
        }
    }
};

template <int ALPHA_NUM, int ALPHA_DEN>
struct EpiResOutX {
    static constexpr bool PERM = false, AFTER_DRAIN = false, EXT = true, PRE = false, PROBE_NOZERO = false;
    static constexpr float alpha = (float)ALPHA_NUM / (float)ALPHA_DEN;
    const bf16_t* xb; const bf16_t* ident; float* outf;
    __device__ __forceinline__ const bf16_t* ext_a() const { return xb; }
    __device__ __forceinline__ const bf16_t* ext_b() const { return ident; }
    __device__ __forceinline__ void operator()(const f32x4 (&acc)[2][2][4][2], const Unit& u, int wr, int wc, int fr, int fq) const {
        const int row0 = u.pm * BM + wr * 64 + fr, col0 = u.pn * BM + wc * 32 + 4 * fq;
#pragma unroll
        for (int ai = 0; ai < 2; ++ai)
#pragma unroll
            for (int m = 0; m < 4; ++m) {
                const size_t off = (size_t)(row0 + ai * HALF + m * 16) * 1024 + col0;
#pragma unroll
                for (int bj = 0; bj < 2; ++bj)
#pragma unroll
                    for (int n = 0; n < 2; ++n) *(f32x4*)(outf + off + bj * HALF + n * 16) = acc[ai][bj][m][n] * alpha;
            }
    }
};

template <int V>
#ifndef PROBE6_PITCH
#define PROBE6_PITCH 1024
#endif
#ifndef PROBE6_LOCAL
#define PROBE6_LOCAL 0
#endif
struct EpiResP {
    static constexpr bool PERM = true, AFTER_DRAIN = false, EXT = false, PRE = false, PROBE_NOZERO = false;
    const bf16_t* xb; bf16_t* dst; float* ssq;
    __device__ __forceinline__ void operator()(const f32x4 (&acc)[2][2][4][2], const Unit& u, int wr, int wc, int fr, int fq) const {
        const int row0 = u.pm * BM + wr * 64 + fr, col0 = u.pn * BM + wc * 32 + 8 * fq;
        if (V & 8) {
            f32x4 t = {0.f, 0.f, 0.f, 0.f};
#pragma unroll
            for (int ai = 0; ai < 2; ++ai)
#pragma unroll
                for (int bj = 0; bj < 2; ++bj)
#pragma unroll
                    for (int m = 0; m < 4; ++m) { t += acc[ai][bj][m][0]; t += acc[ai][bj][m][1]; }
            const float q = (t[0] + t[1]) + (t[2] + t[3]);
            if (__builtin_bit_cast(unsigned, q) == 0x7fc1abcdu) ssq[row0] = q;
            return;
        }
#pragma unroll
        for (int ai = 0; ai < 2; ++ai) {
            u32x4 bw[4][2];
#pragma unroll
            for (int m = 0; m < 4; ++m)
#pragma unroll
                for (int bj = 0; bj < 2; ++bj) bw[m][bj] = (V & 1) ? *(const u32x4*)(xb + (size_t)(row0 + ai * HALF + m * 16) * PROBE6_PITCH + col0 + bj * HALF) : (u32x4){0u, 0u, 0u, 0u};
#pragma unroll
            for (int m = 0; m < 4; ++m) {
                const int row = row0 + ai * HALF + m * 16;
                const size_t off = (size_t)(PROBE6_LOCAL ? (row & 255) + 256 * (int)(blockIdx.x) : row) * PROBE6_PITCH + col0;
                float sq = 0.f;
#pragma unroll
                for (int bj = 0; bj < 2; ++bj) {
                    const u32x4 b_ = bw[m][bj];
                    f32x4 b0, b1;
                    b0[0] = __builtin_bit_cast(float, b_.x << 16); b0[1] = __builtin_bit_cast(float, b_.x & 0xffff0000u); b0[2] = __builtin_bit_cast(float, b_.y << 16); b0[3] = __builtin_bit_cast(float, b_.y & 0xffff0000u);
                    b1[0] = __builtin_bit_cast(float, b_.z << 16); b1[1] = __builtin_bit_cast(float, b_.z & 0xffff0000u); b1[2] = __builtin_bit_cast(float, b_.w << 16); b1[3] = __builtin_bit_cast(float, b_.w & 0xffff0000u);
                    const f32x4 o0 = b0 + acc[ai][bj][m][0], o1 = b1 + acc[ai][bj][m][1];
                    if ((V & 2) && (!(V & 16) || ai == 0)) { u32x4 w; w.x = cvt_pk_bf16(o0[0], o0[1]); w.y = cvt_pk_bf16(o0[2], o0[3]); w.z = cvt_pk_bf16(o1[0], o1[1]); w.w = cvt_pk_bf16(o1[2], o1[3]);
#ifndef PROBE6_NT
#define PROBE6_NT 0
#endif
#ifndef PROBE6_FULL
#define PROBE6_FULL 0
#endif
                        if (PROBE6_FULL) {
                            const int lane_ = fr + 16 * fq, k_ = (ai * 4 + m) * 2 + bj, L_ = ((wr * 4 + wc) * 16 + k_) * 8 + (lane_ >> 3);
                            if (PROBE6_FULL == 1) *(u32x4*)(dst + (size_t)(u.pm * BM + (L_ >> 2)) * PROBE6_PITCH + u.pn * BM + (L_ & 3) * 64 + (lane_ & 7) * 8) = w;
                            else if (PROBE6_FULL == 2) *(u32x4*)(dst + (size_t)(u.pm * BM + ai * HALF + wr * 64 + m * 16 + bj * 8 + (lane_ >> 3)) * PROBE6_PITCH + u.pn * BM + wc * 64 + (lane_ & 7) * 8) = w;
                            else if (PROBE6_FULL == 4) *(u32x4*)(dst + (size_t)(u.pm * BM + ai * HALF + wr * 64 + m * 16 + bj * 8 + (fr & 7)) * PROBE6_PITCH + u.pn * BM + wc * 64 + ((fr >> 3) * 4 + fq) * 8) = w;
                            else *(u32x4*)(dst + (size_t)row * PROBE6_PITCH + u.pn * BM + wc * 64 + bj * 32 + 8 * fq) = w; }
                        else if (PROBE6_NT) __builtin_nontemporal_store(w, (u32x4*)(dst + off + bj * HALF)); else *(u32x4*)(dst + off + bj * HALF) = w; }
                    sq += (o0[0] * o0[0] + o0[1] * o0[1]) + (o0[2] * o0[2] + o0[3] * o0[3]) + (o1[0] * o1[0] + o1[1] * o1[1]) + (o1[2] * o1[2] + o1[3] * o1[3]);
                }
                if (V & 4) { sq += __shfl_xor(sq, 16); sq += __shfl_xor(sq, 32); if (fq == 0) atomicAdd(ssq + row, sq); }
                else if (V & 16) { if (__builtin_bit_cast(unsigned, sq) == 0x7fc1abcdu) ssq[row] = sq; }
            }
            asm volatile("" ::: "memory");
        }
    }
};

struct EpiProj {
    static constexpr bool PERM = true, PERM2 = true, STAGED = true, AFTER_DRAIN = false, EXT = false;
    bf16_t* P; int ldp; const float* ss; const float* qg; const float* kg; float qscale; const float* og;
    static constexpr bool PRE = true, PROBE_NOZERO = false;
    __device__ __forceinline__ void preload(float (&rsv)[2][4], const Unit& u, int wr, int fr) const {
        const int row0 = u.pm * BM + wr * 64 + fr;
#pragma unroll
        for (int ai = 0; ai < 2; ++ai)
#pragma unroll
            for (int m = 0; m < 4; ++m) asm volatile("global_load_dword %0, %1, off" : "=v"(rsv[ai][m]) : "v"(ss + row0 + ai * HALF + m * 16) : "memory");
    }
    __device__ __forceinline__ void operator()(const f32x4 (&acc)[2][2][4][2], const Unit& u, int wr, int wc, int fr, int fq, const float (&rsv)[2][4], PG8_LAS unsigned char* sb) const {
        const int row0 = u.pm * BM + wr * 64 + fr; const int pn = u.pn;
        const int lane = fr + 16 * fq;
        PG8_LAS unsigned char* lnptr = sb + fr * 144 + fq * 16;
        const PG8_LAS unsigned char* gptr = sb + (lane >> 3) * 144 + (lane & 7) * 16;
        bf16_t* sptr = P + (size_t)(u.pm * BM + wr * 64 + (lane >> 3)) * ldp + pn * BM + wc * 64 + (lane & 7) * 8;
#define EPIPROJ_FLUSH(ai_, m_) do { const u32x4 s0_ = *(const PG8_LAS u32x4*)(gptr), s1_ = *(const PG8_LAS u32x4*)(gptr + 8 * 144); \
            bf16_t* sp_ = sptr + (size_t)((ai_) * HALF + (m_) * 16) * ldp; *(u32x4*)(sp_) = s0_; *(u32x4*)(sp_ + (size_t)8 * ldp) = s1_; } while (0)
        if (pn >= 6 && pn <= 9) {
            const float* gp = (pn < 8) ? qg : kg; const float gs = (pn < 8) ? qscale : 1.0f;
            float gn[2][8];
#pragma unroll
            for (int bj = 0; bj < 2; ++bj)
#pragma unroll
                for (int j = 0; j < 8; ++j) gn[bj][j] = gp[32 * bj + 8 * fq + j] * gs;
#pragma unroll
            for (int ai = 0; ai < 2; ++ai)
#pragma unroll
                for (int m = 0; m < 4; ++m) {
                    const int row = row0 + ai * HALF + m * 16;
                    const float r = __builtin_amdgcn_rsqf(rsv[ai][m] * (1.0f / 1024.0f) + NORM_EPS);
                    float v[2][8]; float sq = 0.f;
#pragma unroll
                    for (int bj = 0; bj < 2; ++bj)
#pragma unroll
                        for (int n = 0; n < 2; ++n)
#pragma unroll
                            for (int i = 0; i < 4; ++i) { const float t = acc[ai][bj][m][n][i] * r; v[bj][4 * n + i] = t; sq += t * t; }
                    sq += __shfl_xor(sq, 16); sq += __shfl_xor(sq, 32);
                    const float rr = __builtin_amdgcn_rsqf(sq * (1.0f / 64.0f) + NORM_EPS);
#pragma unroll
                    for (int bj = 0; bj < 2; ++bj) {
                        u32x4 w; w.x = cvt_pk_bf16(v[bj][0] * rr * gn[bj][0], v[bj][1] * rr * gn[bj][1]); w.y = cvt_pk_bf16(v[bj][2] * rr * gn[bj][2], v[bj][3] * rr * gn[bj][3]);
                        w.z = cvt_pk_bf16(v[bj][4] * rr * gn[bj][4], v[bj][5] * rr * gn[bj][5]); w.w = cvt_pk_bf16(v[bj][6] * rr * gn[bj][6], v[bj][7] * rr * gn[bj][7]);
                        *(PG8_LAS u32x4*)(lnptr + bj * 64) = w;
                    }
                    EPIPROJ_FLUSH(ai, m);
                }
        } else {
            const float sc = (pn == 0) ? 0.125f : 1.0f;
            const bool skip_hi = (pn == 12);
            const bool gate_tile = (pn == 4 || pn == 5);
            f32x4 gn0[2] = {{1.f, 1.f, 1.f, 1.f}, {1.f, 1.f, 1.f, 1.f}}, gn1[2] = {{1.f, 1.f, 1.f, 1.f}, {1.f, 1.f, 1.f, 1.f}};
            if (gate_tile) {
#pragma unroll
                for (int bj = 0; bj < 2; ++bj) { gn0[bj] = *(const f32x4*)(og + (wc & 1) * 64 + bj * 32 + 8 * fq); gn1[bj] = *(const f32x4*)(og + (wc & 1) * 64 + bj * 32 + 8 * fq + 4); } }
#pragma unroll
            for (int ai = 0; ai < 2; ++ai)
#pragma unroll
                for (int m = 0; m < 4; ++m) {
                    const int row = row0 + ai * HALF + m * 16;
                    const float r = __builtin_amdgcn_rsqf(rsv[ai][m] * (1.0f / 1024.0f) + NORM_EPS) * sc;
#pragma unroll
                    for (int bj = 0; bj < 2; ++bj) {
                        f32x4 v0 = acc[ai][bj][m][0] * r, v1 = acc[ai][bj][m][1] * r;
                        if (gate_tile) {
#pragma unroll
                            for (int i = 0; i < 4; ++i) { v0[i] = silu_f(v0[i]) * gn0[bj][i]; v1[i] = silu_f(v1[i]) * gn1[bj][i]; } }
                        u32x4 w; w.x = cvt_pk_bf16(v0[0], v0[1]); w.y = cvt_pk_bf16(v0[2], v0[3]); w.z = cvt_pk_bf16(v1[0], v1[1]); w.w = cvt_pk_bf16(v1[2], v1[3]);
                        *(PG8_LAS u32x4*)(lnptr + bj * 64) = w;
                    }
                    if (!skip_hi || wc == 0) EPIPROJ_FLUSH(ai, m);
                }
        }
    }
#undef EPIPROJ_FLUSH
};

template <class E, class = void> struct has_perm2 : std::false_type {};
template <class E> struct has_perm2<E, std::void_t<decltype(E::PERM2)>> : std::bool_constant<E::PERM2> {};
template <class E, class = void> struct has_pfa : std::false_type {};
template <class E> struct has_pfa<E, std::void_t<decltype(E::PFA)>> : std::bool_constant<E::PFA> {};
template <class E, class = void> struct has_staged : std::false_type {};
template <class E> struct has_staged<E, std::void_t<decltype(E::STAGED)>> : std::bool_constant<E::STAGED> {};
template <class Epi, class Sched, bool ALIGN_EPI = false, bool SP2 = false>
__device__ __forceinline__ void gemm_phase(PG8_LAS unsigned char* lds, const Gemm g, const Sched& S, const Epi& E) {
    const int tid = threadIdx.x, wid = __builtin_amdgcn_readfirstlane(tid >> 6), lane = tid & 63, wr = wid >> 2, wc = wid & 3, fr = lane & 15, fq = lane >> 4;
    constexpr bool EXT = Epi::EXT;
    constexpr bool PERM2 = has_perm2<Epi>::value, STAGED = has_staged<Epi>::value;
    constexpr unsigned XS = 1024u * 2u, IS = 256u * 2u;
    const int K = g.K, ntK = K / BK, nt = ntK + (EXT ? 4 : 0);
    const unsigned KS = (unsigned)K * 2u;
    unsigned voffA[2], voffB[2], cbx[2];
#pragma unroll
    for (int i = 0; i < 2; ++i) { int R, C; stage_rc(tid * 16 + i * 8192, R, C); const int Rb = PERM2 ? (64 * (R >> 5) + (Epi::PERM ? perm32(R & 31) : (R & 31))) : Epi::PERM ? ((R & ~31) + perm32(R & 31)) : R;
        if constexpr (EXT) { voffA[i] = (unsigned)R; voffB[i] = (unsigned)Rb; cbx[i] = (unsigned)C * 2u; }
        else { voffA[i] = (unsigned)(R * g.lda + C) * 2u; voffB[i] = (unsigned)(Rb * g.ldb + C) * 2u; cbx[i] = 0u; } }
    const size_t kstep = (size_t)(BK * 2);
    const size_t hstepA = (size_t)HALF * g.lda * 2, hstepB = (size_t)(PERM2 ? 32 : HALF) * g.ldb * 2;
    const size_t tstepA = (size_t)BM * g.lda * 2, tstepB = (size_t)BM * g.ldb * 2;
    const unsigned ldsw = (unsigned)wid * 1024u;
    const int aoff = lds_byte(wr * 64 + fr, fq * 8), boff = lds_byte(wc * 32 + fr, fq * 8);
#define PG8_SA(b, h) (((b) * 2 + (h)) * HTB)
#define PG8_SB(b, h) ((4 + (b) * 2 + (h)) * HTB)
#define PG8_STAGE(bufoff, gbase, voff) do { _Pragma("unroll") for (int _i = 0; _i < 2; ++_i) \
        __builtin_amdgcn_global_load_lds((const unsigned*)((const char*)(gbase) + (EXT ? (voff)[_i] * KS + cbx[_i] : (voff)[_i])), (PG8_LAS unsigned*)(lds + (bufoff) + ldsw + _i * 8192), 16, 0, 0); } while (0)
#define PG8_STAGE_S(bufoff, gbase, rv, stride) do { _Pragma("unroll") for (int _i = 0; _i < 2; ++_i) \
        __builtin_amdgcn_global_load_lds((const unsigned*)((const char*)(gbase) + ((rv)[_i] * (stride) + cbx[_i])), (PG8_LAS unsigned*)(lds + (bufoff) + ldsw + _i * 8192), 16, 0, 0); } while (0)
#define PG8_LDA(dst, b, h) do { _Pragma("unroll") for (int m = 0; m < 4; ++m) _Pragma("unroll") for (int k = 0; k < 2; ++k) dst[m][k] = *(const PG8_LAS bf16x8*)(lds + PG8_SA(b, h) + aoff + m * 2048 + k * 1024); } while (0)
#define PG8_LDB(dst, b, h) do { _Pragma("unroll") for (int n = 0; n < 2; ++n) _Pragma("unroll") for (int k = 0; k < 2; ++k) dst[n][k] = *(const PG8_LAS bf16x8*)(lds + PG8_SB(b, h) + boff + n * 2048 + k * 1024); } while (0)
#define PG8_MMA(ai, bj, At, Bt) do { __builtin_amdgcn_s_setprio(1); _Pragma("unroll") for (int m = 0; m < 4; ++m) _Pragma("unroll") for (int n = 0; n < 2; ++n) _Pragma("unroll") for (int k = 0; k < 2; ++k) \
        acc[ai][bj][m][n] = __builtin_amdgcn_mfma_f32_16x16x32_bf16(Bt[n][k], At[m][k], acc[ai][bj][m][n], 0, 0, 0); __builtin_amdgcn_s_setprio(0); } while (0)
#define PG8_WAIT_V(n) asm volatile("s_waitcnt vmcnt(" #n ")" ::: "memory")
#define PG8_WAIT_L(n) asm volatile("s_waitcnt lgkmcnt(" #n ")" ::: "memory")
#define PG8_BAR __builtin_amdgcn_s_barrier()
#define PG8_SCHED __builtin_amdgcn_sched_barrier(0)
    Unit cur, nxt; int ui = 0;
    if (!S.next(0, cur)) return;
    f32x4 acc[2][2][4][2];
#pragma unroll
    for (int a = 0; a < 2; ++a)
#pragma unroll
        for (int b = 0; b < 2; ++b)
#pragma unroll
            for (int m = 0; m < 4; ++m)
#pragma unroll
                for (int n = 0; n < 2; ++n) acc[a][b][m][n] = (f32x4){0.f, 0.f, 0.f, 0.f};
    bf16x8 At[4][2], B0[2][2], B1[2][2];
    const char* cA = (const char*)g.A + (size_t)cur.pm * tstepA; const char* cB = (const char*)g.Bt + (size_t)cur.pn * tstepB;
    S.a_ready(cur);
    float pre[2][4];
    if constexpr (Epi::PRE) E.preload(pre, cur, wr, fr);
    if constexpr (SP2) {
        PG8_STAGE(PG8_SB(0, 0), cB, voffB); PG8_STAGE(PG8_SB(0, 1), cB + hstepB, voffB); PG8_STAGE(PG8_SA(0, 0), cA, voffA); PG8_STAGE(PG8_SA(0, 1), cA + hstepA, voffA);
        if (wr == 1) PG8_BAR;
        PG8_WAIT_V(2); PG8_BAR;
        PG8_STAGE(PG8_SB(1, 0), cB + kstep, voffB); PG8_STAGE(PG8_SA(1, 0), cA + kstep, voffA); PG8_STAGE(PG8_SB(1, 1), cB + hstepB + kstep, voffB);
        PG8_WAIT_V(6); PG8_BAR;
    } else {
        PG8_STAGE(PG8_SB(0, 0), cB, voffB); PG8_STAGE(PG8_SA(0, 0), cA, voffA); PG8_STAGE(PG8_SB(0, 1), cB + hstepB, voffB); PG8_STAGE(PG8_SA(0, 1), cA + hstepA, voffA);
        if (wr == 1) PG8_BAR;
        PG8_WAIT_V(4); PG8_BAR;
        PG8_STAGE(PG8_SB(1, 0), cB + kstep, voffB); PG8_STAGE(PG8_SA(1, 0), cA + kstep, voffA); PG8_STAGE(PG8_SB(1, 1), cB + hstepB + kstep, voffB);
        PG8_WAIT_V(6); PG8_BAR;
    }
    for (;;) {
        const bool has_next = S.next(ui + 1, nxt);
        const char* nA = has_next ? (const char*)g.A + (size_t)nxt.pm * tstepA : cA; const char* nB = has_next ? (const char*)g.Bt + (size_t)nxt.pn * tstepB : cB;
        const char* xA = nullptr; const char* iB = nullptr;
        if constexpr (EXT) { xA = (const char*)E.ext_a() + ((size_t)cur.pm * BM * 1024 + (size_t)cur.pn * BM) * 2; iB = (const char*)E.ext_b(); }
        for (int t = 0; t < nt; t += 2) {
            const bool last = (t == nt - 2);
            if constexpr (EXT) {
            static_assert(SP2, "the extension tiles are written for the two-super-phase loop");
            const bool e1 = (t >= ntK), e2 = !last && (t + 2 >= ntK);
            const char* a1 = e1 ? xA + (size_t)(t + 1 - ntK) * kstep : cA + (size_t)(t + 1) * kstep;
            const unsigned sA1 = e1 ? XS : KS; const size_t hA1 = e1 ? (size_t)HALF * XS : hstepA;
            const char* a2 = last ? nA : e2 ? xA + (size_t)(t + 2 - ntK) * kstep : cA + (size_t)(t + 2) * kstep;
            const char* b2 = last ? nB : e2 ? iB + (size_t)(t + 2 - ntK) * kstep : cB + (size_t)(t + 2) * kstep;
            const unsigned sA2 = e2 ? XS : KS, sB2 = e2 ? IS : KS; const size_t hA2 = e2 ? (size_t)HALF * XS : hstepA, hB2 = e2 ? (size_t)HALF * IS : hstepB;
            const char* a3 = a2 + kstep; const char* b3 = b2 + kstep;
            if (last && has_next) S.a_ready(nxt);
            PG8_LDB(B0, 0, 0); PG8_LDB(B1, 0, 1); PG8_SCHED; PG8_LDA(At, 0, 0); PG8_STAGE_S(PG8_SA(1, 1), a1 + hA1, voffA, sA1);
            PG8_WAIT_V(8); PG8_WAIT_L(0); PG8_BAR; PG8_MMA(0, 0, At, B0); PG8_MMA(0, 1, At, B1); PG8_BAR; PG8_SCHED;
            PG8_LDA(At, 0, 1); PG8_STAGE_S(PG8_SB(0, 0), b2, voffB, sB2); PG8_STAGE_S(PG8_SB(0, 1), b2 + hB2, voffB, sB2); PG8_STAGE_S(PG8_SA(0, 0), a2, voffA, sA2);
            PG8_WAIT_V(8); PG8_WAIT_L(0); PG8_BAR; PG8_MMA(1, 0, At, B0); PG8_MMA(1, 1, At, B1); PG8_BAR; PG8_SCHED;
            PG8_LDB(B0, 1, 0); PG8_LDB(B1, 1, 1); PG8_SCHED; PG8_LDA(At, 1, 0); PG8_STAGE_S(PG8_SA(0, 1), a2 + hA2, voffA, sA2);
            PG8_WAIT_V(8); PG8_WAIT_L(0); PG8_BAR; PG8_MMA(0, 0, At, B0); PG8_MMA(0, 1, At, B1); PG8_BAR; PG8_SCHED;
            PG8_LDA(At, 1, 1); PG8_STAGE_S(PG8_SB(1, 0), b3, voffB, sB2); PG8_STAGE_S(PG8_SB(1, 1), b3 + hB2, voffB, sB2); PG8_STAGE_S(PG8_SA(1, 0), a3, voffA, sA2);
            PG8_WAIT_V(8); PG8_WAIT_L(0); PG8_BAR; PG8_MMA(1, 0, At, B0); PG8_MMA(1, 1, At, B1); PG8_BAR; PG8_SCHED;
            continue;
            }
            const char* a1 = cA + (size_t)(t + 1) * kstep;
            const char* a2 = last ? nA : cA + (size_t)(t + 2) * kstep; const char* b2 = last ? nB : cB + (size_t)(t + 2) * kstep;
            const char* a3 = a2 + kstep; const char* b3 = b2 + kstep;
            if (last && has_next) S.a_ready(nxt);
            if constexpr (SP2) {
            PG8_LDB(B0, 0, 0); PG8_LDB(B1, 0, 1); PG8_SCHED; PG8_LDA(At, 0, 0); PG8_STAGE(PG8_SA(1, 1), a1 + hstepA, voffA);
            PG8_WAIT_V(8); PG8_WAIT_L(0); PG8_BAR; PG8_MMA(0, 0, At, B0); PG8_MMA(0, 1, At, B1); PG8_BAR; PG8_SCHED;
            PG8_LDA(At, 0, 1); PG8_STAGE(PG8_SB(0, 0), b2, voffB); PG8_STAGE(PG8_SB(0, 1), b2 + hstepB, voffB); PG8_STAGE(PG8_SA(0, 0), a2, voffA);
            PG8_WAIT_V(8); PG8_WAIT_L(0); PG8_BAR; PG8_MMA(1, 0, At, B0); PG8_MMA(1, 1, At, B1); PG8_BAR; PG8_SCHED;
            PG8_LDB(B0, 1, 0); PG8_LDB(B1, 1, 1); PG8_SCHED; PG8_LDA(At, 1, 0); PG8_STAGE(PG8_SA(0, 1), a2 + hstepA, voffA);
            PG8_WAIT_V(8); PG8_WAIT_L(0); PG8_BAR; PG8_MMA(0, 0, At, B0); PG8_MMA(0, 1, At, B1); PG8_BAR; PG8_SCHED;
            PG8_LDA(At, 1, 1); PG8_STAGE(PG8_SB(1, 0), b3, voffB); PG8_STAGE(PG8_SB(1, 1), b3 + hstepB, voffB); PG8_STAGE(PG8_SA(1, 0), a3, voffA);
            PG8_WAIT_V(8); PG8_WAIT_L(0); PG8_BAR; PG8_MMA(1, 0, At, B0); PG8_MMA(1, 1, At, B1); PG8_BAR; PG8_SCHED;
            } else {
            PG8_LDB(B0, 0, 0); PG8_SCHED; PG8_LDA(At, 0, 0); PG8_STAGE(PG8_SA(1, 1), a1 + hstepA, voffA);
            PG8_WAIT_L(8); PG8_BAR; PG8_WAIT_L(0); PG8_MMA(0, 0, At, B0); PG8_BAR; PG8_SCHED;
            PG8_LDB(B1, 0, 1); PG8_STAGE(PG8_SB(0, 0), b2, voffB);
            PG8_BAR; PG8_WAIT_L(0); PG8_MMA(0, 1, At, B1); PG8_BAR;
            PG8_LDA(At, 0, 1); PG8_STAGE(PG8_SA(0, 0), a2, voffA);
            PG8_BAR; PG8_WAIT_L(0); PG8_MMA(1, 0, At, B0); PG8_BAR; PG8_SCHED;
            PG8_STAGE(PG8_SB(0, 1), b2 + hstepB, voffB);
            PG8_WAIT_V(6); PG8_BAR; PG8_MMA(1, 1, At, B1); PG8_BAR;
            PG8_LDB(B0, 1, 0); PG8_SCHED; PG8_LDA(At, 1, 0); PG8_STAGE(PG8_SA(0, 1), a2 + hstepA, voffA);
            PG8_WAIT_L(8); PG8_BAR; PG8_WAIT_L(0); PG8_MMA(0, 0, At, B0); PG8_BAR; PG8_SCHED;
            PG8_LDB(B1, 1, 1); PG8_STAGE(PG8_SB(1, 0), b3, voffB);
            PG8_BAR; PG8_WAIT_L(0); PG8_MMA(0, 1, At, B1); PG8_BAR;
            PG8_LDA(At, 1, 1); PG8_STAGE(PG8_SA(1, 0), a3, voffA);
            PG8_BAR; PG8_WAIT_L(0); PG8_MMA(1, 0, At, B0); PG8_BAR; PG8_SCHED;
            PG8_STAGE(PG8_SB(1, 1), b3 + hstepB, voffB);
            PG8_WAIT_V(6); PG8_BAR; PG8_MMA(1, 1, At, B1); PG8_BAR;
            }
        }
        if constexpr (ALIGN_EPI) { if (wr == 0) PG8_BAR; }
        if constexpr (!Epi::AFTER_DRAIN) { if constexpr (Epi::PRE && STAGED) E(acc, cur, wr, wc, fr, fq, pre, lds + STAGE_BYTES + wid * 3072); else if constexpr (Epi::PRE) E(acc, cur, wr, wc, fr, fq, pre); else if constexpr (STAGED) E(acc, cur, wr, wc, fr, fq, lds + STAGE_BYTES + wid * 3072); else E(acc, cur, wr, wc, fr, fq); S.done(cur); }
        if (!has_next) break;
#ifndef PG8_PROBE_NOZERO
#define PG8_PROBE_NOZERO 0
#endif
        if (!(PG8_PROBE_NOZERO && Epi::PROBE_NOZERO))
#pragma unroll
        for (int a = 0; a < 2; ++a)
#pragma unroll
            for (int b = 0; b < 2; ++b)
#pragma unroll
                for (int m = 0; m < 4; ++m)
#pragma unroll
                    for (int n = 0; n < 2; ++n) acc[a][b][m][n] = (f32x4){0.f, 0.f, 0.f, 0.f};
        cur = nxt; cA = nA; cB = nB; ++ui;
        if constexpr (Epi::PRE) E.preload(pre, cur, wr, fr);
        if constexpr (ALIGN_EPI) { if (wr == 1) PG8_BAR; }
    }
    PG8_WAIT_V(0);
    if constexpr (!ALIGN_EPI) { if (wr == 0) PG8_BAR; }
    PG8_BAR;
    if constexpr (Epi::AFTER_DRAIN) { E.fused(acc, cur, wr, wc, fr, fq, lds, wid, lane); S.done(cur); }
#undef PG8_SA
#undef PG8_SB
#undef PG8_STAGE
#undef PG8_STAGE_S
#undef PG8_LDA
#undef PG8_LDB
#undef PG8_MMA
#undef PG8_WAIT_V
#undef PG8_WAIT_L
#undef PG8_BAR
#undef PG8_SCHED
}
}
#define GAS __attribute__((address_space(1)))
#define LAS __attribute__((address_space(3)))
typedef unsigned short bf16;
typedef unsigned v4u __attribute__((ext_vector_type(4)));
typedef float f32x4 __attribute__((ext_vector_type(4)));
typedef short bf16x8 __attribute__((ext_vector_type(8)));
typedef GAS unsigned gu32;
typedef GAS unsigned long long gu64;
#define RLX_AGENT __ATOMIC_RELAXED, __HIP_MEMORY_SCOPE_AGENT
#define LDS_WAIT() asm volatile("s_waitcnt lgkmcnt(0)" ::: "memory")
#define VM_WAIT() asm volatile("s_waitcnt vmcnt(0)" ::: "memory")
__device__ __forceinline__ unsigned long long rt() { return __builtin_amdgcn_s_memrealtime(); }
__device__ __forceinline__ unsigned f2bf(float f) { unsigned u = __builtin_bit_cast(unsigned, f); return (u + 0x7fffu + ((u >> 16) & 1u)) >> 16; }
__device__ __forceinline__ unsigned pk2(float lo, float hi) { return f2bf(lo) | (f2bf(hi) << 16); }

#define XB_TMO      128
#define XB_XCNT(j)  (256  + 64 * (j))
#define XB_XSUB(j)  (1280 + 64 * (j))
#define XB_XGEN(j)  (2304 + 64 * (j))
#define XB_TOP      3328
#define XB_TOPGEN   3392
#define XCD_BAR_WORDS 3456
#define XB_SPIN_CAP (1u << 18)

__device__ __forceinline__ unsigned xb_ld(unsigned* p)              { return __hip_atomic_load(p, __ATOMIC_RELAXED, __HIP_MEMORY_SCOPE_AGENT); }
__device__ __forceinline__ unsigned xb_add(unsigned* p, unsigned v) { return __hip_atomic_fetch_add(p, v, __ATOMIC_RELAXED, __HIP_MEMORY_SCOPE_AGENT); }
__device__ __forceinline__ unsigned xb_xcc_id() { return (unsigned)__builtin_amdgcn_s_getreg((3 << 11) | 20) & 0xFu; }
#define XB_SPIN(cond, bar) do { unsigned _sp = 0; while (cond) { __builtin_amdgcn_s_sleep(1); \
    if ((++_sp & 255u) == 0u) { if (xb_ld(&(bar)[XB_TMO])) break; if (_sp > XB_SPIN_CAP) { atomicAdd(&(bar)[XB_TMO], 1u); break; } } } } while (0)

struct XcdBarrier {
    unsigned* bar; unsigned x;
    volatile LAS unsigned* st;
};

__device__ __forceinline__ XcdBarrier xcd_barrier_post(unsigned* bar, volatile LAS unsigned* st) {
    XcdBarrier b; b.bar = bar; b.x = xb_xcc_id(); b.st = st;
    if (threadIdx.x == 0) (void)xb_add(&bar[XB_XCNT(b.x)], 1u);
    return b;
}
__device__ __forceinline__ void xcd_barrier_complete(unsigned* bar, unsigned x, unsigned& nloc, unsigned& nx) {
    const unsigned G = gridDim.x * gridDim.y * gridDim.z;
    unsigned sum, cnt, mine, sp = 0u;
    for (;;) {
        sum = 0u; cnt = 0u; mine = 0u;
#pragma unroll
        for (unsigned j = 0; j < 16; ++j) { const unsigned c = xb_ld(&bar[XB_XCNT(j)]); sum += c; cnt += (c > 0u) ? 1u : 0u; mine = (j == x) ? c : mine; }
        if (sum == G) break;
        __builtin_amdgcn_s_sleep(1);
        if ((++sp & 255u) == 0u) { if (xb_ld(&bar[XB_TMO])) break; if (sp > XB_SPIN_CAP) { atomicAdd(&bar[XB_TMO], 1u); break; } }
    }
    nloc = mine > 0u ? mine : 1u; nx = cnt > 0u ? cnt : 1u;
}

__device__ __forceinline__ void xcd_barrier(const XcdBarrier& b) {
    asm volatile("s_waitcnt vmcnt(0)" ::: "memory");
    __syncthreads();
    if (threadIdx.x == 0) {
        unsigned* bar = b.bar;
        __builtin_amdgcn_s_waitcnt(0);
        unsigned nloc = b.st[0], nx = b.st[1];
        if (nloc == 0u) { xcd_barrier_complete(bar, b.x, nloc, nx); b.st[0] = nloc; b.st[1] = nx; }
        const unsigned old = xb_add(&bar[XB_XSUB(b.x)], 1u);
        const unsigned gen = old / nloc;
        if (old + 1u == (gen + 1u) * nloc) {
            __builtin_amdgcn_fence(__ATOMIC_RELEASE, "agent");
            asm volatile("s_waitcnt vmcnt(0)" ::: "memory");
            const unsigned og = xb_add(&bar[XB_TOP], 1u);
            const unsigned tg = og / nx;
            if (og + 1u == (tg + 1u) * nx) xb_add(&bar[XB_TOPGEN], 1u);
            else XB_SPIN(xb_ld(&bar[XB_TOPGEN]) == tg, bar);
            __builtin_amdgcn_fence(__ATOMIC_ACQUIRE, "agent");
            xb_add(&bar[XB_XGEN(b.x)], 1u);
            asm volatile("s_waitcnt vmcnt(0)" ::: "memory");
        } else {
            XB_SPIN(xb_ld(&bar[XB_XGEN(b.x)]) == gen, bar);
            __builtin_amdgcn_fence(__ATOMIC_ACQUIRE, "agent");
            asm volatile("s_waitcnt vmcnt(0)" ::: "memory");
        }
    }
    __syncthreads();
}

__device__ __forceinline__ void xcd_barrier_local(const XcdBarrier& b) {
    asm volatile("s_waitcnt vmcnt(0)" ::: "memory");
    __syncthreads();
    if (threadIdx.x == 0) {
        unsigned* bar = b.bar;
        __builtin_amdgcn_s_waitcnt(0);
        unsigned nloc = b.st[0], nx = b.st[1];
        if (nloc == 0u) { xcd_barrier_complete(bar, b.x, nloc, nx); b.st[0] = nloc; b.st[1] = nx; }
        const unsigned old = xb_add(&bar[XB_XSUB(b.x)], 1u);
        const unsigned gen = old / nloc;
        if (old + 1u == (gen + 1u) * nloc) {
            __builtin_amdgcn_fence(__ATOMIC_ACQUIRE, "agent");
            xb_add(&bar[XB_XGEN(b.x)], 1u);
            asm volatile("s_waitcnt vmcnt(0)" ::: "memory");
        } else {
            XB_SPIN(xb_ld(&bar[XB_XGEN(b.x)]) == gen, bar);
            __builtin_amdgcn_fence(__ATOMIC_ACQUIRE, "agent");
            asm volatile("s_waitcnt vmcnt(0)" ::: "memory");
        }
    }
    __syncthreads();
}


constexpr int NWAVES = 8;
constexpr int BATCH = 16, SEQ = 4096, DM = 1024, MROWS = BATCH * SEQ, DFF = 2816;
constexpr int GLA_H = 4, GLA_DK = 64, GLA_DV = 128, GLA_RANK = 16, SB_H = 8, SB_D = 64;
constexpr int NPROJ = 3328;
constexpr int PC_GQ = 0, PC_GK = 256, PC_GV = 512, PC_GG = 1024, PC_SQ = 1536, PC_SK = 2048, PC_SV = 2560, PC_LR = 3072;
constexpr int SRC_GQ = 0, SRC_GK = 256, SRC_GV = 512, SRC_GG = 1024, SRC_LR = 1536, SRC_SQ = 1552, SRC_SK = 2064, SRC_SV = 2576, D_IN = 3088;
constexpr float EPS = 1e-6f;
constexpr int XLD = 1088, MLD = 1088, WLD = 1024;
constexpr int ALD = 2816, PLD = 3328;
constexpr float SBQ_SCALE = 0.125f * 1.4426950408889634f;

constexpr size_t MiB = 1u << 20;
constexpr size_t WS_CTL = 0, CTL_ZERO_BYTES = 2 * MiB;
constexpr size_t WS_SS1 = 1 * MiB, WS_SS2 = 1 * MiB + 256 * 1024, WS_SS0 = 1 * MiB + 512 * 1024;
constexpr size_t WS_W1 = 2 * MiB;
constexpr size_t WS_WD1 = WS_W1 + (size_t)2 * DFF * DM * 2;
constexpr size_t WS_WIN = WS_WD1 + (size_t)DM * DFF * 2;
constexpr size_t WS_WOUT = WS_WIN + (size_t)NPROJ * DM * 2;
constexpr size_t WS_W2 = WS_WOUT + (size_t)DM * DM * 2;
constexpr size_t WS_WD2 = WS_W2 + (size_t)2 * DFF * DM * 2;
constexpr size_t WS_WEND = WS_WD2 + (size_t)DM * DFF * 2;
static_assert(WS_WEND <= 60 * MiB, "weights");
constexpr size_t WS_ID1 = 60 * MiB, WS_ID2 = 60 * MiB + 256 * 1024;
constexpr size_t WS_XB = 64 * MiB;
constexpr size_t WS_MIX = 200 * MiB;
constexpr size_t WS_BIG = 336 * MiB;
constexpr size_t WS_END = WS_BIG + (size_t)MROWS * PLD * 2;
static_assert(WS_XB + (size_t)MROWS * XLD * 2 <= WS_MIX && WS_MIX + (size_t)MROWS * MLD * 2 <= WS_BIG, "d_ws map");
constexpr int CW_BAR = 4096;
constexpr int CW_GMASK = 2048;
constexpr int CW_WORK = 1024;

constexpr int RING_OFF = 0, RING_BYTES = 155648;
constexpr int LDSCTL_OFF = RING_BYTES, MISC_OFF = LDSCTL_OFF + 320;
constexpr int LDS_BYTES = 163840;


namespace sb {
typedef short bf16x8 __attribute__((ext_vector_type(8)));
typedef short s16x4 __attribute__((ext_vector_type(4)));
typedef float f32x16 __attribute__((ext_vector_type(16)));
typedef unsigned u32x4 __attribute__((ext_vector_type(4)));
typedef unsigned short bf16;
constexpr int QB = 256, KVBLK = 64, SLOTB = 8192;
constexpr int NRING = 6, LDS_OST = NRING * 2 * SLOTB, LDS_BYTES = LDS_OST + 8 * 4096;
__device__ __forceinline__ int crow(int r, int hi) { return (r & 3) + 8 * (r >> 2) + 4 * hi; }
__device__ __forceinline__ void glds16(const void* gsrc, unsigned lds_dst) { unsigned keep;
    asm volatile("s_mov_b32 %0, m0\n\ts_mov_b32 m0, %2\n\ts_nop 0\n\tglobal_load_lds_dwordx4 %1, off\n\ts_mov_b32 m0, %0" : "=&s"(keep) : "v"(gsrc), "s"(lds_dst) : "memory"); }
typedef float f32x2_t __attribute__((ext_vector_type(2))); typedef __bf16 bf16x2_t __attribute__((ext_vector_type(2)));
__device__ __forceinline__ unsigned cvtpk(float lo, float hi) { f32x2_t v = {lo, hi}; bf16x2_t b = __builtin_convertvector(v, bf16x2_t); return __builtin_bit_cast(unsigned, b); }
typedef short v4i16_t __attribute__((ext_vector_type(4)));
#define SB_LAS __attribute__((address_space(3)))
__device__ __forceinline__ s16x4 trd(const SB_LAS unsigned char* p) { return __builtin_bit_cast(s16x4, __builtin_amdgcn_ds_read_tr16_b64_v4i16((SB_LAS v4i16_t*)p)); }
#define SB_SBAR() __builtin_amdgcn_sched_barrier(0)
#define SB_WAIT_BAR(N) asm volatile("s_waitcnt vmcnt(" #N ") lgkmcnt(0)\n\ts_barrier" ::: "memory")

__device__ __forceinline__ void qkt(f32x16& p0, f32x16& p1, const char* Kslot, const bf16x8* qr, int r32, int hi) {
    const char* kb = Kslot + hi * 1024 + r32 * 16;
    const f32x16 z = {};
#pragma unroll
    for (int d0 = 0; d0 < 4; ++d0) {
        const bf16x8 b0 = *reinterpret_cast<const bf16x8*>(kb + d0 * 2048);
        const bf16x8 b1 = *reinterpret_cast<const bf16x8*>(kb + d0 * 2048 + 512);
        if (d0 == 0) { p0 = __builtin_amdgcn_mfma_f32_32x32x16_bf16(b0, qr[0], z, 0, 0, 0); p1 = __builtin_amdgcn_mfma_f32_32x32x16_bf16(b1, qr[0], z, 0, 0, 0); }
        else { p0 = __builtin_amdgcn_mfma_f32_32x32x16_bf16(b0, qr[d0], p0, 0, 0, 0); p1 = __builtin_amdgcn_mfma_f32_32x32x16_bf16(b1, qr[d0], p1, 0, 0, 0); } }
}
__device__ __forceinline__ void pv(f32x16* o, int vb, bf16x8 pa0, bf16x8 pa1, bf16x8 pa2, bf16x8 pa3) {
#pragma unroll
    for (int d0 = 0; d0 < 2; ++d0) { s16x4 lo[4], hi[4];
#pragma unroll
        for (int ks = 0; ks < 4; ++ks) {
            asm volatile("ds_read_b64_tr_b16 %0,%1 offset:%c2" : "=&v"(lo[ks]) : "v"(vb), "i"(d0 * 4096 + ks * 1024) : "memory");
            asm volatile("ds_read_b64_tr_b16 %0,%1 offset:%c2" : "=&v"(hi[ks]) : "v"(vb), "i"(d0 * 4096 + ks * 1024 + 512) : "memory"); }
        asm volatile("s_waitcnt lgkmcnt(0)" ::: "memory"); SB_SBAR();
#define SB_PK(k) (bf16x8){lo[k][0], lo[k][1], lo[k][2], lo[k][3], hi[k][0], hi[k][1], hi[k][2], hi[k][3]}
        o[d0] = __builtin_amdgcn_mfma_f32_32x32x16_bf16(pa0, SB_PK(0), o[d0], 0, 0, 0);
        o[d0] = __builtin_amdgcn_mfma_f32_32x32x16_bf16(pa1, SB_PK(1), o[d0], 0, 0, 0);
        o[d0] = __builtin_amdgcn_mfma_f32_32x32x16_bf16(pa2, SB_PK(2), o[d0], 0, 0, 0);
        o[d0] = __builtin_amdgcn_mfma_f32_32x32x16_bf16(pa3, SB_PK(3), o[d0], 0, 0, 0);
#undef SB_PK
    }
}

template <bool EXIT, int NB>
__device__ __forceinline__ void sb_unit(int b, int h, int qb_hi, const bf16* P, int pitch, int cq, int ck, int cv, bf16* O, int opitch, int co, int seq, char* shm, __attribute__((address_space(3))) unsigned char* lds3) {
    const int tid = threadIdx.x, lane = tid & 63, r32 = lane & 31, hi = lane >> 5; const int wid = __builtin_amdgcn_readfirstlane(tid >> 6);
    const long rowbase = (long)b * seq;
    const bf16* Kh = P + rowbase * pitch + ck + h * 64; const bf16* Vh = P + rowbase * pitch + cv + h * 64;
    const unsigned lds0 = (unsigned)(uintptr_t)shm;
    const bf16* ksrc = Kh + (long)lane * pitch + wid * 8;
    const bf16* vsrc = Vh + (long)(16 * (wid & 3) + (lane >> 2)) * pitch + (wid >> 2) * 32 + (lane & 3) * 8;
    const unsigned kdst = lds0 + wid * 1024, vdst = lds0 + SLOTB + wid * 1024;
#define SB_DMA_KV(t, pos) do { const int t_ = (t) < 0 ? 0 : (t); \
        glds16(ksrc + (long)t_ * KVBLK * pitch, (unsigned)__builtin_amdgcn_readfirstlane(kdst + (pos) * 2 * SLOTB)); \
        glds16(vsrc + (long)t_ * KVBLK * pitch, (unsigned)__builtin_amdgcn_readfirstlane(vdst + (pos) * 2 * SLOTB)); } while (0)
#define SB_PROLOGUE_DMA(tb_) do { SB_DMA_KV((tb_) + 3, 0); SB_DMA_KV((tb_) + 2, 1); SB_DMA_KV((tb_) + 1, 2); SB_DMA_KV((tb_), 3); SB_DMA_KV((tb_) - 1, 4); } while (0)
    const int pw_ = wid >> 1;
    volatile __attribute__((address_space(3))) int* DONEW0 = (volatile __attribute__((address_space(3))) int*)(lds3 + LDS_BYTES);
    if (lane == 0) {
#pragma unroll
        for (int k = 0; k < NB; ++k) DONEW0[8 * k + wid] = 1000; }
    bf16x8 qr[NB][4];
#pragma unroll
    for (int k = 0; k < NB; ++k) { const bf16* Qw = P + (rowbase + (long)(qb_hi - k) * QB + wid * 32) * pitch + cq + h * 64;
#pragma unroll
        for (int d0 = 0; d0 < 4; ++d0) qr[k][d0] = *reinterpret_cast<const bf16x8*>(&Qw[(long)r32 * pitch + d0 * 16 + hi * 8]); }
    SB_PROLOGUE_DMA(4 * qb_hi);
    bf16x8 triA[2], onesA;
#pragma unroll
    for (int s = 0; s < 2; ++s)
#pragma unroll
        for (int j = 0; j < 8; ++j) { const int kk = 16 * s + 8 * (j >> 2) + 4 * hi + (j & 3); triA[s][j] = (kk > r32) ? (short)0xBF80 : (short)0; }
#pragma unroll
    for (int j = 0; j < 8; ++j) onesA[j] = (short)0xBF80;
#pragma unroll
    for (int k = 0; k < NB; ++k) asm volatile("" :: "v"(qr[k][0]), "v"(qr[k][1]), "v"(qr[k][2]), "v"(qr[k][3]));
#pragma unroll
    for (int k = 0; k < NB; ++k) {
    const int qb = qb_hi - k, q0 = qb * QB, qw = q0 + wid * 32, tb = 4 * qb;
    volatile __attribute__((address_space(3))) int* DONEW = DONEW0 + 8 * k;
    f32x16 o[2]; o[0] = f32x16{}; o[1] = f32x16{};
    float R = 0.f;
    const int tq = qw + r32;
    bool mydone = false;
    const int nsteps = tb + 4;
    int posn = 5;
    int posw = 3 - pw_;
    for (int i = 0; i < nsteps; ++i) {
        if (k > 0 && i == 0) SB_WAIT_BAR(4); else SB_WAIT_BAR(2);
        if (EXIT) { int cnt = 0;
#pragma unroll
            for (int w = 0; w < 8; ++w) cnt += (DONEW[w] < i) ? 1 : 0;
            if (cnt == 8) break; }
        SB_DMA_KV(tb - (i + 2), posn);
        posn = (posn == 5) ? 0 : posn + 1;
        const int t = tb + pw_ - i;
        if (!mydone && t < 0) { mydone = true; if (lane == 0) DONEW[wid] = i; }
        if (!mydone) {
            const int slot = posw * 2 * SLOTB;
            auto tile = [&](auto diag_c) {
                constexpr bool DIAG = decltype(diag_c)::value;
                f32x16 p0, p1;
                qkt(p0, p1, shm + slot, qr[k], r32, hi);
                bf16x8 vfr[8];
                { const SB_LAS unsigned char* vp = lds3 + slot + SLOTB + ((lane >> 4) & 1) * 32 + (lane & 3) * 8 + (4 * hi + ((lane & 15) >> 2)) * 64;
#pragma unroll
                  for (int f = 0; f < 8; ++f) { const s16x4 lo = trd(vp + (f >> 2) * 4096 + (f & 3) * 1024), hh = trd(vp + (f >> 2) * 4096 + (f & 3) * 1024 + 512);
                      vfr[f] = (bf16x8){lo[0], lo[1], lo[2], lo[3], hh[0], hh[1], hh[2], hh[3]}; } }
                const int kbase = t * KVBLK + 4 * hi;
                const float zr0 = p0[0] + R;
                f32x16 c0, c1;
#pragma unroll
                for (int r = 0; r < 16; ++r) {
                    float s0 = __builtin_amdgcn_logf(1.0f + __builtin_amdgcn_exp2f(p0[r]));
                    float s1 = __builtin_amdgcn_logf(1.0f + __builtin_amdgcn_exp2f(p1[r]));
                    if (DIAG) { const int kv = kbase + (r & 3) + 8 * (r >> 2); if (kv >= tq) s0 = 0.f; if (kv + 32 >= tq) s1 = 0.f; }
                    c0[r] = (p0[r] - s0) + R; c1[r] = (p1[r] - s1) + R;
                    p0[r] = s0; p1[r] = s1;
                }
                u32x4 sb0a, sb0b, sb1a, sb1b;
                sb0a = (u32x4){cvtpk(p0[0], p0[1]), cvtpk(p0[2], p0[3]), cvtpk(p0[4], p0[5]), cvtpk(p0[6], p0[7])};
                sb0b = (u32x4){cvtpk(p0[8], p0[9]), cvtpk(p0[10], p0[11]), cvtpk(p0[12], p0[13]), cvtpk(p0[14], p0[15])};
                sb1a = (u32x4){cvtpk(p1[0], p1[1]), cvtpk(p1[2], p1[3]), cvtpk(p1[4], p1[5]), cvtpk(p1[6], p1[7])};
                sb1b = (u32x4){cvtpk(p1[8], p1[9]), cvtpk(p1[10], p1[11]), cvtpk(p1[12], p1[13]), cvtpk(p1[14], p1[15])};
#define SB_F(x) __builtin_bit_cast(bf16x8, x)
                c0 = __builtin_amdgcn_mfma_f32_32x32x16_bf16(triA[0], SB_F(sb0a), c0, 0, 0, 0);
                c1 = __builtin_amdgcn_mfma_f32_32x32x16_bf16(triA[0], SB_F(sb1a), c1, 0, 0, 0);
                c0 = __builtin_amdgcn_mfma_f32_32x32x16_bf16(triA[1], SB_F(sb0b), c0, 0, 0, 0);
                c1 = __builtin_amdgcn_mfma_f32_32x32x16_bf16(triA[1], SB_F(sb1b), c1, 0, 0, 0);
                c0 = __builtin_amdgcn_mfma_f32_32x32x16_bf16(onesA, SB_F(sb1a), c0, 0, 0, 0);
                c0 = __builtin_amdgcn_mfma_f32_32x32x16_bf16(onesA, SB_F(sb1b), c0, 0, 0, 0);
                { const float tot = zr0 - c0[0]; auto rr = __builtin_amdgcn_permlane32_swap(__float_as_uint(tot), __float_as_uint(tot), false, false); R -= __uint_as_float(rr[0]); }
                if (EXIT) { if (__all(R < -134.0f)) { mydone = true; if (lane == 0) DONEW[wid] = i; } }
#pragma unroll
                for (int r = 0; r < 16; ++r) {
                    float w0 = __builtin_amdgcn_exp2f(c0[r]), w1 = __builtin_amdgcn_exp2f(c1[r]);
                    if (DIAG) { const int kv = kbase + (r & 3) + 8 * (r >> 2); if (kv >= tq) w0 = 0.f; if (kv + 32 >= tq) w1 = 0.f; }
                    p0[r] = w0; p1[r] = w1;
                }
                u32x4 pw0, pw1, pw2, pw3;
                pw0 = (u32x4){cvtpk(p0[0], p0[1]), cvtpk(p0[2], p0[3]), cvtpk(p0[4], p0[5]), cvtpk(p0[6], p0[7])};
                pw1 = (u32x4){cvtpk(p0[8], p0[9]), cvtpk(p0[10], p0[11]), cvtpk(p0[12], p0[13]), cvtpk(p0[14], p0[15])};
                pw2 = (u32x4){cvtpk(p1[0], p1[1]), cvtpk(p1[2], p1[3]), cvtpk(p1[4], p1[5]), cvtpk(p1[6], p1[7])};
                pw3 = (u32x4){cvtpk(p1[8], p1[9]), cvtpk(p1[10], p1[11]), cvtpk(p1[12], p1[13]), cvtpk(p1[14], p1[15])};
                o[0] = __builtin_amdgcn_mfma_f32_32x32x16_bf16(SB_F(pw0), vfr[0], o[0], 0, 0, 0); o[1] = __builtin_amdgcn_mfma_f32_32x32x16_bf16(SB_F(pw0), vfr[4], o[1], 0, 0, 0);
                o[0] = __builtin_amdgcn_mfma_f32_32x32x16_bf16(SB_F(pw1), vfr[1], o[0], 0, 0, 0); o[1] = __builtin_amdgcn_mfma_f32_32x32x16_bf16(SB_F(pw1), vfr[5], o[1], 0, 0, 0);
                o[0] = __builtin_amdgcn_mfma_f32_32x32x16_bf16(SB_F(pw2), vfr[2], o[0], 0, 0, 0); o[1] = __builtin_amdgcn_mfma_f32_32x32x16_bf16(SB_F(pw2), vfr[6], o[1], 0, 0, 0);
                o[0] = __builtin_amdgcn_mfma_f32_32x32x16_bf16(SB_F(pw3), vfr[3], o[0], 0, 0, 0); o[1] = __builtin_amdgcn_mfma_f32_32x32x16_bf16(SB_F(pw3), vfr[7], o[1], 0, 0, 0);
#undef SB_F
            };
            if (i == 0) tile(std::true_type{}); else tile(std::false_type{});
        }
        posw = (posw == 5) ? 0 : posw + 1;
    }
    asm volatile("s_waitcnt vmcnt(0)" ::: "memory");
    if (k + 1 < NB) SB_PROLOGUE_DMA(4 * (qb - 1));
    bf16* Ow = O + (rowbase + qw) * opitch + co + h * 64;
    { bf16* stg = (bf16*)(shm + LDS_OST) + wid * 2048;
#pragma unroll
      for (int r = 0; r < 16; ++r) { const int orow = crow(r, hi);
#pragma unroll
          for (int d0 = 0; d0 < 2; ++d0) stg[orow * 64 + d0 * 32 + r32] = (bf16)(cvtpk(o[d0][r], 0.f) & 0xffffu); }
      asm volatile("s_waitcnt lgkmcnt(0)" ::: "memory");
#pragma unroll
      for (int i = 0; i < 4; ++i) { const int row = i * 8 + (lane >> 3), ch = lane & 7; const u32x4 v = *(const u32x4*)(stg + row * 64 + ch * 8); *(u32x4*)(Ow + (long)row * opitch + ch * 8) = v; } }
    }
    asm volatile("s_waitcnt lgkmcnt(0)\n\ts_barrier" ::: "memory");
#undef SB_PROLOGUE_DMA
#undef SB_DMA_KV
}
#undef SB_LAS
#undef SB_SBAR
#undef SB_WAIT_BAR
}

namespace gla {
typedef short bf16x8 __attribute__((ext_vector_type(8)));
typedef short s16x4 __attribute__((ext_vector_type(4)));
typedef float f32x16 __attribute__((ext_vector_type(16)));
typedef float f32x4 __attribute__((ext_vector_type(4)));
typedef unsigned u32x4 __attribute__((ext_vector_type(4)));
typedef unsigned short bf16;
#define GLA_LAS __attribute__((address_space(3)))
#define GLA_GAS __attribute__((address_space(1)))
#define GLA_SCHED() __builtin_amdgcn_sched_barrier(0)
#define GLA_BAR() asm volatile("s_waitcnt lgkmcnt(0)\n\ts_barrier" ::: "memory")
constexpr float LOG2E = 1.4426950408889634f;
constexpr int REC_BYTES = 32768, REC_QD = 0, REC_KI = 8192, REC_KE = 16384, REC_DEC = 24576;
constexpr int BLS = 68;
constexpr int PL_CW = 0, PL_CT = 4096, PL_BL = 8192;
constexpr int SET_BYTES = 43008, S_QD = 0, S_KI = 8192, S_KE = 16384, S_VT = 24576, S_DEC = 40960;
constexpr int L_OS = 2 * SET_BYTES, L_GT = L_OS + 32768, L_GN = L_GT + 32768, L_END = L_GN + 512;
typedef float f32x2_t __attribute__((ext_vector_type(2))); typedef __bf16 bf16x2_t __attribute__((ext_vector_type(2)));
__device__ __forceinline__ unsigned cvtpk(float lo, float hi) { f32x2_t v = {lo, hi}; bf16x2_t b = __builtin_convertvector(v, bf16x2_t); return __builtin_bit_cast(unsigned, b); }
__device__ __forceinline__ float blo(unsigned w) { return __builtin_bit_cast(float, w << 16); }
__device__ __forceinline__ float bhi(unsigned w) { return __builtin_bit_cast(float, w & 0xffff0000u); }
__device__ __forceinline__ int crow(int r, int hi) { return (r & 3) + 8 * (r >> 2) + 4 * hi; }
typedef short v4i16_t __attribute__((ext_vector_type(4)));
__device__ __forceinline__ s16x4 trd(const GLA_LAS unsigned char* p) { return __builtin_bit_cast(s16x4, __builtin_amdgcn_ds_read_tr16_b64_v4i16((GLA_LAS v4i16_t*)p)); }
__device__ __forceinline__ bf16x8 pack8(const f32x16& x, int base) {
    u32x4 w = {cvtpk(x[base + 0], x[base + 1]), cvtpk(x[base + 2], x[base + 3]), cvtpk(x[base + 4], x[base + 5]), cvtpk(x[base + 6], x[base + 7])};
    return __builtin_bit_cast(bf16x8, w); }
__device__ __forceinline__ void unpack8(const u32x4& w, float* f) { f[0] = blo(w.x); f[1] = bhi(w.x); f[2] = blo(w.y); f[3] = bhi(w.y); f[4] = blo(w.z); f[5] = bhi(w.z); f[6] = blo(w.w); f[7] = bhi(w.w); }
__device__ __forceinline__ void glds16(const void* gsrc, unsigned lds_dst) { unsigned keep;
    asm volatile("s_mov_b32 %0, m0\n\ts_mov_b32 m0, %2\n\ts_nop 0\n\tglobal_load_lds_dwordx4 %1, off\n\ts_mov_b32 m0, %0" : "=&s"(keep) : "v"(gsrc), "s"(lds_dst) : "memory"); }

struct PrepLoads { u32x4 lrA0, lrA1, q8[4], k8[4]; };
__device__ __forceinline__ void prep_load(PrepLoads& L, int u, const bf16* P, int pitch, int cq, int ck, int clr, int seq) {
    const int tid = threadIdx.x, lane = tid & 63, r32 = lane & 31, hi = lane >> 5; const int wid = __builtin_amdgcn_readfirstlane(tid >> 6);
    const int tok = tid >> 3, sub = tid & 7, cj = wid >> 1;
    const int g = u & 15, bh = u >> 4, b = bh >> 2, h = bh & 3;
    const size_t row0 = (size_t)b * seq + (size_t)g * 256;
    const bf16* lrow = P + (row0 + cj * 64 + r32) * pitch + clr + 8 * hi;
    L.lrA0 = *(const GLA_GAS u32x4*)(lrow); L.lrA1 = *(const GLA_GAS u32x4*)(lrow + (size_t)32 * pitch);
#pragma unroll
    for (int j = 0; j < 4; ++j) { const bf16* pr = P + (row0 + j * 64 + tok) * pitch; L.q8[j] = *(const GLA_GAS u32x4*)(pr + cq + h * 64 + sub * 8); L.k8[j] = *(const GLA_GAS u32x4*)(pr + ck + h * 64 + sub * 8); }
}
__device__ __forceinline__ void prep_unit(const PrepLoads& L, int u, unsigned char* REC, const float* wup, const float* bgk, GLA_LAS unsigned char* lds) {
    const int tid = threadIdx.x, lane = tid & 63, r32 = lane & 31, hi = lane >> 5; const int wid = __builtin_amdgcn_readfirstlane(tid >> 6);
    const int tok = tid >> 3, sub = tid & 7;
    const int cj = wid >> 1, dkh = wid & 1;
    const int g = u & 15, bh = u >> 4, b = bh >> 2, h = bh & 3;
    GLA_LAS unsigned char* CW = lds + PL_CW; GLA_LAS unsigned char* CT = lds + PL_CT; GLA_LAS float* BL = (GLA_LAS float*)(lds + PL_BL);
    const u32x4 lrA0 = L.lrA0, lrA1 = L.lrA1;
    float bgl;
    { const int dkc = h * 64 + 32 * dkh + r32; bgl = bgk[dkc] * LOG2E;
      if (wid < 2) { bf16x8 wB_hi, wB_lo;
#pragma unroll
          for (int j = 0; j < 8; ++j) { const float wv = wup[(8 * hi + j) * 256 + dkc] * LOG2E; const unsigned hb = cvtpk(wv, 0.f) & 0xffffu; const float lov = wv - __builtin_bit_cast(float, hb << 16);
              wB_hi[j] = (short)hb; wB_lo[j] = (short)(cvtpk(lov, 0.f) & 0xffffu); }
          *(GLA_LAS bf16x8*)(CW + wid * 2048 + lane * 16) = wB_hi; *(GLA_LAS bf16x8*)(CW + wid * 2048 + 1024 + lane * 16) = wB_lo; }
      if (wid == 2) {
#pragma unroll
          for (int s = 0; s < 2; ++s) { bf16x8 t;
#pragma unroll
              for (int j = 0; j < 8; ++j) { const int kk = 16 * s + 8 * (j >> 2) + 4 * hi + (j & 3); t[j] = (kk <= r32) ? (short)0x3F80 : (short)0; }
              *(GLA_LAS bf16x8*)(CT + s * 1024 + lane * 16) = t; } } }
    GLA_BAR();
    unsigned char* rec0 = REC + ((size_t)(b * 4 + h) * 64 + (size_t)g * 4) * REC_BYTES;
    {   const bf16x8 wB_hi = *(const GLA_LAS bf16x8*)(CW + dkh * 2048 + lane * 16), wB_lo = *(const GLA_LAS bf16x8*)(CW + dkh * 2048 + 1024 + lane * 16);
        const bf16x8 tri0 = *(const GLA_LAS bf16x8*)(CT + lane * 16), tri1 = *(const GLA_LAS bf16x8*)(CT + 1024 + lane * 16);
        bf16x8 onesP;
#pragma unroll
        for (int j = 0; j < 8; ++j) onesP[j] = (short)0x3F80;
        GLA_LAS float* BLc = BL + cj * 64 * BLS;
        f32x16 b0 = {}, b1 = {};
#pragma unroll
        for (int T = 0; T < 2; ++T) {
            f32x16 x;
#pragma unroll
            for (int r = 0; r < 16; ++r) x[r] = bgl;
            const bf16x8 af = __builtin_bit_cast(bf16x8, T ? lrA1 : lrA0);
            x = __builtin_amdgcn_mfma_f32_32x32x16_bf16(af, wB_hi, x, 0, 0, 0);
            x = __builtin_amdgcn_mfma_f32_32x32x16_bf16(af, wB_lo, x, 0, 0, 0);
#pragma unroll
            for (int r = 0; r < 16; ++r) x[r] = (fminf(x[r], 0.f) - __builtin_amdgcn_logf(1.0f + __builtin_amdgcn_exp2f(-fabsf(x[r])))) * (1.0f / 16.0f);
            const bf16x8 hA = pack8(x, 0), hB = pack8(x, 8);
#pragma unroll
            for (int r = 0; r < 16; ++r) x[r] -= __builtin_bit_cast(float, (unsigned)(unsigned short)((r < 8) ? hA[r & 7] : hB[r & 7]) << 16);
            const bf16x8 lA = pack8(x, 0), lB = pack8(x, 8);
            if (T == 0) {
                b0 = __builtin_amdgcn_mfma_f32_32x32x16_bf16(tri0, hA, b0, 0, 0, 0); b1 = __builtin_amdgcn_mfma_f32_32x32x16_bf16(onesP, hA, b1, 0, 0, 0);
                b0 = __builtin_amdgcn_mfma_f32_32x32x16_bf16(tri1, hB, b0, 0, 0, 0); b1 = __builtin_amdgcn_mfma_f32_32x32x16_bf16(onesP, hB, b1, 0, 0, 0);
                b0 = __builtin_amdgcn_mfma_f32_32x32x16_bf16(tri0, lA, b0, 0, 0, 0); b1 = __builtin_amdgcn_mfma_f32_32x32x16_bf16(onesP, lA, b1, 0, 0, 0);
                b0 = __builtin_amdgcn_mfma_f32_32x32x16_bf16(tri1, lB, b0, 0, 0, 0); b1 = __builtin_amdgcn_mfma_f32_32x32x16_bf16(onesP, lB, b1, 0, 0, 0);
#pragma unroll
                for (int r = 0; r < 16; ++r) BLc[crow(r, hi) * BLS + 32 * dkh + r32] = b0[r];
            } else {
                b1 = __builtin_amdgcn_mfma_f32_32x32x16_bf16(tri0, hA, b1, 0, 0, 0); b1 = __builtin_amdgcn_mfma_f32_32x32x16_bf16(tri1, hB, b1, 0, 0, 0);
                b1 = __builtin_amdgcn_mfma_f32_32x32x16_bf16(tri0, lA, b1, 0, 0, 0); b1 = __builtin_amdgcn_mfma_f32_32x32x16_bf16(tri1, lB, b1, 0, 0, 0);
#pragma unroll
                for (int r = 0; r < 16; ++r) BLc[(32 + crow(r, hi)) * BLS + 32 * dkh + r32] = b1[r];
                if (hi) *(GLA_GAS float*)(rec0 + (size_t)cj * REC_BYTES + REC_DEC + (32 * dkh + r32) * 4) = __builtin_amdgcn_exp2f(b1[15]);
            }
        }
    }
    GLA_BAR();
#pragma unroll
    for (int j = 0; j < 4; ++j) {
        const GLA_LAS float* BLc = BL + j * 64 * BLS;
        float qf[8], kf[8]; unpack8(L.q8[j], qf); unpack8(L.k8[j], kf);
        float qd[8], ki[8];
#pragma unroll
        for (int e = 0; e < 8; ++e) { const float bb = BLc[tok * BLS + 8 * sub + e];
            qd[e] = qf[e] * __builtin_amdgcn_exp2f(bb); ki[e] = kf[e] * __builtin_amdgcn_exp2f(-bb); }
        unsigned char* rec = rec0 + (size_t)j * REC_BYTES;
        *(GLA_GAS u32x4*)(rec + REC_QD + sub * 1024 + tok * 16) = (u32x4){cvtpk(qd[0], qd[1]), cvtpk(qd[2], qd[3]), cvtpk(qd[4], qd[5]), cvtpk(qd[6], qd[7])};
        *(GLA_GAS u32x4*)(rec + REC_KE + (sub >> 2) * 4096 + tok * 64 + (sub & 3) * 16) = (u32x4){cvtpk(ki[0], ki[1]), cvtpk(ki[2], ki[3]), cvtpk(ki[4], ki[5]), cvtpk(ki[6], ki[7])};
    }
    GLA_BAR();
}

__device__ __forceinline__ void gla_unit(int b, int h, const bf16* P, int pitch, int cv, int cg, const unsigned char* REC, bf16* MIX, int opitch, int seq,
                                         const float* gon, GLA_LAS unsigned char* lds, const char* shm, bool hot = false) {
    const int tid = threadIdx.x, lane = tid & 63, r32 = lane & 31, hi = lane >> 5; const int wid = __builtin_amdgcn_readfirstlane(tid >> 6);
    const int tok = tid >> 3, sub = tid & 7;
    const int th = wid >> 2, c = wid & 3;
    GLA_LAS float* GN = (GLA_LAS float*)(lds + L_GN);
    if (tid < 128) GN[tid] = gon[tid];
    const unsigned lds0 = (unsigned)(uintptr_t)shm;
    const unsigned char* rec0 = REC + (size_t)(b * 4 + h) * 64 * REC_BYTES;
    const bf16* prow = P + ((size_t)b * seq + tok) * pitch;
    const int va = wid & 3, vb = va + 4;
#define GLA_VSRC(v, i) (P + ((size_t)b * seq + 16 * ((2 * (v) + (i)) & 3) + (lane >> 2)) * pitch + cv + h * 128 + 32 * ((2 * (v) + (i)) >> 2) + 8 * (lane & 3))
#define GLA_GSRC(v) (P + ((size_t)b * seq + 8 * (v) + (lane >> 4)) * pitch + cg + h * 128 + 8 * (lane & 15))
    const bf16* vsA0 = GLA_VSRC(va, 0); const bf16* vsA1 = GLA_VSRC(va, 1); const bf16* vsB0 = GLA_VSRC(vb, 0); const bf16* vsB1 = GLA_VSRC(vb, 1);
    const bf16* gsA = GLA_GSRC(va); const bf16* gsB = GLA_GSRC(vb);
#define GLA_DMA_SLOT(n, set, v, vs0, vs1) do { const unsigned char* r_ = rec0 + (size_t)(n) * REC_BYTES; const unsigned sb_ = lds0 + (set) * SET_BYTES; \
        glds16(r_ + REC_QD + (v) * 1024 + lane * 16, (unsigned)__builtin_amdgcn_readfirstlane(sb_ + S_QD + (v) * 1024)); \
        glds16(r_ + REC_KE + (v) * 1024 + lane * 16, (unsigned)__builtin_amdgcn_readfirstlane(sb_ + S_KE + (v) * 1024)); \
        glds16((vs0) + (size_t)(n) * 64 * pitch, (unsigned)__builtin_amdgcn_readfirstlane(sb_ + S_VT + (2 * (v)) * 1024)); \
        glds16((vs1) + (size_t)(n) * 64 * pitch, (unsigned)__builtin_amdgcn_readfirstlane(sb_ + S_VT + (2 * (v) + 1) * 1024)); } while (0)
#define GLA_DMA(n, set) do { if (wid < 4) { GLA_DMA_SLOT(n, set, va, vsA0, vsA1); GLA_DMA_SLOT(n, set, vb, vsB0, vsB1); \
        if (wid == 0) glds16(rec0 + (size_t)(n) * REC_BYTES + REC_DEC + lane * 16, (unsigned)__builtin_amdgcn_readfirstlane(lds0 + (set) * SET_BYTES + S_DEC)); } } while (0)
#define GLA_GATE_SLOT(n, gb, v, gs) do { const unsigned gd_ = lds0 + L_GT + (gb) * 16384 + (2 * (v)) * 1024; \
        glds16((gs) + (size_t)(n) * 64 * pitch, (unsigned)__builtin_amdgcn_readfirstlane(gd_)); \
        glds16((gs) + ((size_t)(n) * 64 + 4) * pitch, (unsigned)__builtin_amdgcn_readfirstlane(gd_ + 1024)); } while (0)
#define GLA_DMA_GATE(n, gb) do { if (wid < 4) { GLA_GATE_SLOT(n, gb, va, gsA); GLA_GATE_SLOT(n, gb, vb, gsB); } } while (0)
    f32x16 S0 = {}, S1 = {};
    const int trl = ((lane >> 4) & 1) * 32 + (lane & 3) * 8 + (4 * hi + ((lane & 15) >> 2)) * 64;
    GLA_LAS bf16* OSB = (GLA_LAS bf16*)(lds + L_OS);
    const int NCH = seq / 64;
    GLA_DMA(0, 0);
    for (int n = 0; n <= NCH; ++n) {
        if (n <= 1) asm volatile("s_waitcnt vmcnt(0) lgkmcnt(0)\n\ts_barrier" ::: "memory");
        else asm volatile("s_waitcnt vmcnt(2) lgkmcnt(0)\n\ts_barrier" ::: "memory");
        const int set = n & 1;
        if (n + 1 < NCH) GLA_DMA(hot ? 0 : n + 1, set ^ 1);
        if (n < NCH) GLA_DMA_GATE(hot ? 0 : n, set);
        GLA_LAS unsigned char* QD = lds + set * SET_BYTES + S_QD; GLA_LAS unsigned char* KI = lds + set * SET_BYTES + S_KI; GLA_LAS unsigned char* KE = lds + set * SET_BYTES + S_KE;
        GLA_LAS unsigned char* VT = lds + set * SET_BYTES + S_VT; GLA_LAS float* DEC = (GLA_LAS float*)(lds + set * SET_BYTES + S_DEC);
#pragma unroll
        for (int half = 0; half < 2; ++half) {
            const bool do5 = (half == 0) ? (th == 0) : (th != 0);
            if (do5) {
                if (n >= 1) {
                    const GLA_LAS bf16* osr = OSB + ((n - 1) & 1) * 8192 + tok * 128 + sub * 16;
                    const u32x4 oa = *(const GLA_LAS u32x4*)(osr), ob = *(const GLA_LAS u32x4*)(osr + 8);
                    float o[16]; unpack8(oa, o); unpack8(ob, o + 8);
                    float sq = 0.f;
#pragma unroll
                    for (int j = 0; j < 16; ++j) sq += o[j] * o[j];
                    sq += __builtin_bit_cast(float, __builtin_amdgcn_update_dpp(0, __builtin_bit_cast(int, sq), 0xB1, 0xF, 0xF, true));
                    sq += __builtin_bit_cast(float, __builtin_amdgcn_update_dpp(0, __builtin_bit_cast(int, sq), 0x4E, 0xF, 0xF, true));
                    sq += __builtin_bit_cast(float, __builtin_amdgcn_update_dpp(0, __builtin_bit_cast(int, sq), 0x141, 0xF, 0xF, true));
                    const float rr = __builtin_amdgcn_rsqf(sq * (1.0f / 128.0f) + 1e-6f);
                    const GLA_LAS bf16* gtr = (const GLA_LAS bf16*)(lds + L_GT) + ((n - 1) & 1) * 8192 + tok * 128 + sub * 16;
                    const u32x4 gp0 = *(const GLA_LAS u32x4*)(gtr), gp1 = *(const GLA_LAS u32x4*)(gtr + 8);
                    float gv[16]; unpack8(gp0, gv); unpack8(gp1, gv + 8);
                    float r8[16];
#pragma unroll
                    for (int i = 0; i < 16; ++i) r8[i] = o[i] * rr * gv[i];
                    bf16* orow = MIX + ((size_t)b * seq + (n - 1) * 64 + tok) * opitch + h * 128 + sub * 16;
                    *(GLA_GAS u32x4*)(orow) = (u32x4){cvtpk(r8[0], r8[1]), cvtpk(r8[2], r8[3]), cvtpk(r8[4], r8[5]), cvtpk(r8[6], r8[7])};
                    *(GLA_GAS u32x4*)(orow + 8) = (u32x4){cvtpk(r8[8], r8[9]), cvtpk(r8[10], r8[11]), cvtpk(r8[12], r8[13]), cvtpk(r8[14], r8[15])};
                }
            } else if (n < NCH) {
                const int qrow = 32 * th + r32;
                bf16x8 qb_[4], ka[4], kb[4], vf[4], af[4];
#pragma unroll
                for (int s = 0; s < 4; ++s) { qb_[s] = *(const GLA_LAS bf16x8*)(QD + (2 * s + hi) * 1024 + qrow * 16); ka[s] = *(const GLA_LAS bf16x8*)(KE + (s >> 1) * 4096 + r32 * 64 + (16 * (s & 1) + 8 * hi) * 2);
                    kb[s] = *(const GLA_LAS bf16x8*)(KE + (s >> 1) * 4096 + (32 + r32) * 64 + (16 * (s & 1) + 8 * hi) * 2); }
#pragma unroll
                for (int ks = 0; ks < 4; ++ks) { const s16x4 lo = trd(VT + c * 4096 + ks * 1024 + trl), hh = trd(VT + c * 4096 + ks * 1024 + 512 + trl);
                    vf[ks] = (bf16x8){lo[0], lo[1], lo[2], lo[3], hh[0], hh[1], hh[2], hh[3]}; }
#pragma unroll
                for (int s = 0; s < 4; ++s) { const s16x4 a0 = *(const GLA_LAS s16x4*)(QD + (2 * s) * 1024 + qrow * 16 + 8 * hi), a1 = *(const GLA_LAS s16x4*)(QD + (2 * s + 1) * 1024 + qrow * 16 + 8 * hi);
                    af[s] = (bf16x8){a0[0], a0[1], a0[2], a0[3], a1[0], a1[1], a1[2], a1[3]}; }
                GLA_SCHED();
                f32x16 X0 = {}, X1 = {};
                if (th) {
#pragma unroll
                    for (int s = 0; s < 4; ++s) { X0 = __builtin_amdgcn_mfma_f32_32x32x16_bf16(ka[s], qb_[s], X0, 0, 0, 0); X1 = __builtin_amdgcn_mfma_f32_32x32x16_bf16(kb[s], qb_[s], X1, 0, 0, 0); }
                } else {
#pragma unroll
                    for (int s = 0; s < 4; ++s) X0 = __builtin_amdgcn_mfma_f32_32x32x16_bf16(ka[s], qb_[s], X0, 0, 0, 0);
                }
                f32x16 O2 = {};
#pragma unroll
                for (int s = 0; s < 4; ++s) { const bf16x8 bfr = (s < 2) ? pack8(S0, 8 * (s & 1)) : pack8(S1, 8 * (s & 1)); O2 = __builtin_amdgcn_mfma_f32_32x32x16_bf16(af[s], bfr, O2, 0, 0, 0); }
                GLA_SCHED();
                bf16x8 kt0[4], kt1[4];
#pragma unroll
                for (int ks = 0; ks < 4; ++ks) {
                    { const s16x4 lo = trd(KE + ks * 1024 + trl), hh = trd(KE + ks * 1024 + 512 + trl); kt0[ks] = (bf16x8){lo[0], lo[1], lo[2], lo[3], hh[0], hh[1], hh[2], hh[3]}; }
                    { const s16x4 lo = trd(KE + 4096 + ks * 1024 + trl), hh = trd(KE + 4096 + ks * 1024 + 512 + trl); kt1[ks] = (bf16x8){lo[0], lo[1], lo[2], lo[3], hh[0], hh[1], hh[2], hh[3]}; } }
                if (th) {
#pragma unroll
                    for (int r = 0; r < 16; ++r) if (crow(r, hi) > r32) X1[r] = 0.f;
                } else {
#pragma unroll
                    for (int r = 0; r < 16; ++r) if (crow(r, hi) > r32) X0[r] = 0.f;
                }
                f32x16 O = {};
                O = __builtin_amdgcn_mfma_f32_32x32x16_bf16(pack8(X0, 0), vf[0], O, 0, 0, 0);
                O = __builtin_amdgcn_mfma_f32_32x32x16_bf16(pack8(X0, 8), vf[1], O, 0, 0, 0);
                if (th) { O = __builtin_amdgcn_mfma_f32_32x32x16_bf16(pack8(X1, 0), vf[2], O, 0, 0, 0); O = __builtin_amdgcn_mfma_f32_32x32x16_bf16(pack8(X1, 8), vf[3], O, 0, 0, 0); }
#pragma unroll
                for (int ks = 0; ks < 4; ++ks) { S0 = __builtin_amdgcn_mfma_f32_32x32x16_bf16(kt0[ks], vf[ks], S0, 0, 0, 0); S1 = __builtin_amdgcn_mfma_f32_32x32x16_bf16(kt1[ks], vf[ks], S1, 0, 0, 0); }
#pragma unroll
                for (int g = 0; g < 4; ++g) { const f32x4 d0 = *(const GLA_LAS f32x4*)(DEC + 8 * g + 4 * hi), d1 = *(const GLA_LAS f32x4*)(DEC + 32 + 8 * g + 4 * hi);
#pragma unroll
                    for (int i = 0; i < 4; ++i) { S0[4 * g + i] *= d0[i]; S1[4 * g + i] *= d1[i]; } }
                { GLA_LAS bf16* osw = OSB + set * 8192 + 32 * th * 128 + 32 * c + r32;
#pragma unroll
                  for (int r = 0; r < 16; r += 2) { const unsigned w = cvtpk(O[r] + O2[r], O[r + 1] + O2[r + 1]); osw[crow(r, hi) * 128] = (bf16)(w & 0xffffu); osw[crow(r + 1, hi) * 128] = (bf16)(w >> 16); } }
            }
        }
    }
    asm volatile("s_waitcnt vmcnt(0) lgkmcnt(0)\n\ts_barrier" ::: "memory");
#undef GLA_DMA
#undef GLA_DMA_GATE
#undef GLA_DMA_SLOT
#undef GLA_GATE_SLOT
#undef GLA_VSRC
#undef GLA_GSRC
}
#undef GLA_LAS
#undef GLA_GAS
#undef GLA_BAR
#undef GLA_SCHED
}

struct Frame {
    LAS unsigned char* lds;
    volatile LAS unsigned* MISC;
    gu32* ctl;
    int tid, lane, wave;
    int vcu, G;
};

__device__ __forceinline__ float wave_sum(float v) {
#pragma unroll
    for (int o = 1; o < 64; o <<= 1) v += __shfl_xor(v, o);
    return v;
}
__device__ __forceinline__ float bf2f(unsigned short b) { return __builtin_bit_cast(float, (unsigned)b << 16); }
__device__ __forceinline__ float bflo(unsigned w) { return __builtin_bit_cast(float, w << 16); }
__device__ __forceinline__ float bfhi(unsigned w) { return __builtin_bit_cast(float, w & 0xffff0000u); }

__device__ __forceinline__ void tr_item(const float* W, int Nsrc, int sc, int nv, const float* gain, bf16* WT, int K, int drow0, int k0, LAS float* scr, int lane) {
    float tv[32];
#pragma unroll
    for (int i = 0; i < 32; ++i) { const int kk = 2 * i + (lane >> 5), n = lane & 31;
        tv[i] = (n < nv) ? W[(size_t)(k0 + kk) * Nsrc + sc + n] : 0.f; }
#pragma unroll
    for (int i = 0; i < 32; ++i) { const int kk = 2 * i + (lane >> 5), n = lane & 31;
        float v = tv[i]; if (gain) v *= gain[k0 + kk];
        scr[kk * 33 + n] = v; }
    LDS_WAIT(); asm volatile("" ::: "memory");
    const int c = lane & 7;
#pragma unroll
    for (int j = 0; j < 4; ++j) { const int n = (lane >> 3) + 8 * j; const LAS float* s = scr + (8 * c) * 33 + n;
        v4u o; o.x = pk2(s[0 * 33], s[1 * 33]); o.y = pk2(s[2 * 33], s[3 * 33]); o.z = pk2(s[4 * 33], s[5 * 33]); o.w = pk2(s[6 * 33], s[7 * 33]);
        *(GAS v4u*)(WT + (size_t)(drow0 + n) * K + k0 + 8 * c) = o; }
    LDS_WAIT(); asm volatile("" ::: "memory");
}
__device__ __forceinline__ void win_map(int db, int& sc, int& nv) {
    const int tile = db >> 3, r = db & 7, bj = r >> 2, wc = r & 3; nv = 32;
    if (tile < 6) sc = 32 * db;
    else if (tile < 8) sc = SRC_SQ + 256 * (tile - 6) + 32 * r;
    else if (tile < 10) sc = SRC_SK + 256 * (tile - 8) + 32 * r;
    else if (tile < 12) sc = SRC_SV + 32 * (db - 80);
    else if (db == 96) { sc = SRC_LR; nv = 16; }
    else { sc = 0; nv = 0; }
}
__device__ __forceinline__ void p0_prologue(Frame& F, const float* const* in, unsigned char* ws, int wmask  ) {
    LAS float* scr = (LAS float*)(F.lds + RING_OFF + F.wave * 16384);
    const int gw = F.vcu * NWAVES + F.wave, NGW = F.G * NWAVES;
    constexpr int I_W = 176 * 16, I_D = 32 * 44, I_IN = 104 * 16, I_O = 32 * 16;
    constexpr int NITEMS = 2 * I_W + 2 * I_D + I_IN + I_O;
    for (int it = gw; it < NITEMS; it += NGW) {
        int r = it;
        if (r < 2 * I_W) { const int second = r >= I_W; if (second) r -= I_W;
            if (!((wmask >> second) & 1)) continue;
            const int kb = r / 176, db = r % 176, tile = db >> 3, q = db & 7, bj = q >> 2, sub = q & 3;
            const float* W = in[second ? (bj ? 15 : 14) : (bj ? 3 : 2)];
            tr_item(W, DFF, 128 * tile + 32 * sub, 32, in[second ? 13 : 1], (bf16*)(ws + (second ? WS_W2 : WS_W1)), DM, 32 * db, 64 * kb, scr, F.lane); continue; }
        r -= 2 * I_W;
        if (r < 2 * I_D) { const int second = r >= I_D; if (second) r -= I_D;
            if (!((wmask >> second) & 1)) continue;
            const int kb = r / 32, db = r % 32;
            tr_item(in[second ? 16 : 4], DM, 32 * db, 32, nullptr, (bf16*)(ws + (second ? WS_WD2 : WS_WD1)), DFF, 32 * db, 64 * kb, scr, F.lane); continue; }
        r -= 2 * I_D;
        if (!(wmask & 1)) continue;
        if (r < I_IN) { const int kb = r / 104, db = r % 104; int sc, nv; win_map(db, sc, nv);
            tr_item(in[6], D_IN, sc, nv, in[5], (bf16*)(ws + WS_WIN), DM, 32 * db, 64 * kb, scr, F.lane); continue; }
        r -= I_IN;
        { const int kb = r / 32, db = r % 32;
            tr_item(in[12], DM, 32 * db, 32, nullptr, (bf16*)(ws + WS_WOUT), DM, 32 * db, 64 * kb, scr, F.lane); }
    }
    if (!(wmask & 1)) return;
    {
        GAS unsigned* i1 = (GAS unsigned*)(ws + WS_ID1); GAS unsigned* i2 = (GAS unsigned*)(ws + WS_ID2);
        for (int idx = F.vcu * (NWAVES * 64) + F.tid; idx < 256 * 128; idx += F.G * NWAVES * 64) { const int n = idx >> 7, k2 = (idx & 127) * 2;
            const unsigned sel = (k2 == n) ? 0x0000ffffu : (k2 + 1 == n) ? 0xffff0000u : 0u;
            i1[idx] = 0x3f803f80u & sel; i2[idx] = 0x40004000u & sel; }
    }
    const float* x = in[0]; bf16* xb = (bf16*)(ws + WS_XB); float* ss0 = (float*)(ws + WS_SS0);
    for (int m0 = gw * 4; m0 < MROWS; m0 += NGW * 4) {
        f32x4 v[4][4];
#pragma unroll
        for (int r = 0; r < 4; ++r) { const GAS f32x4* xr = (const GAS f32x4*)(x + (size_t)(m0 + r) * DM) + F.lane;
#pragma unroll
            for (int j = 0; j < 4; ++j) v[r][j] = __builtin_nontemporal_load(xr + 64 * j); }
#pragma unroll
        for (int r = 0; r < 4; ++r) { float s = 0.f;
#pragma unroll
            for (int j = 0; j < 4; ++j) s += (v[r][j].x * v[r][j].x + v[r][j].y * v[r][j].y) + (v[r][j].z * v[r][j].z + v[r][j].w * v[r][j].w);
            s = wave_sum(s);
            GAS unsigned long long* o8 = (GAS unsigned long long*)(xb + (size_t)(m0 + r) * XLD) + F.lane;
#pragma unroll
            for (int j = 0; j < 4; ++j) o8[64 * j] = (unsigned long long)pk2(v[r][j].x, v[r][j].y) | ((unsigned long long)pk2(v[r][j].z, v[r][j].w) << 32);
            if (F.lane == 0) ss0[m0 + r] = s; }
    }
}

#ifndef PROBE_HOT
#define PROBE_HOT 0
#endif
#ifndef REP4
#define REP4 1
#endif
#ifndef PROBE_MASK
#define PROBE_MASK 2
#endif
#ifndef SB_EXIT
#define SB_EXIT true
#endif
#ifndef MIX_STEAL_MAX
#define MIX_STEAL_MAX 0
#endif
__device__ __forceinline__ void p4_mix(Frame& F, const float* const* in, unsigned char* ws, const float* out_scratch, unsigned char* lds_generic, int rep, bool affine) {
    unsigned* ctr = (unsigned*)(F.ctl + CW_WORK + 64 * rep);
    int qg = (int)(blockIdx.x & 7), qtry = 0;
    for (;;) {
        unsigned u;
        if (affine) {
            if (F.tid == 0) { unsigned n_; int g_ = qg, t_ = qtry;
                for (;;) { n_ = atomicAdd(ctr + 8 + g_, 1u); if (n_ < 264u || t_ >= MIX_STEAL_MAX) break; ++t_; g_ = (g_ + 1) & 7; }
                F.MISC[0] = n_; F.MISC[1] = (unsigned)g_; F.MISC[2] = (unsigned)t_; }
            __syncthreads();
            const unsigned n = F.MISC[0]; qg = (int)F.MISC[1]; qtry = (int)F.MISC[2];
            __syncthreads();
            if (n >= 264u) break;
            if (n < 8u) u = (unsigned)((2 * qg + (int)(n >> 2)) * 4 + (int)(n & 3));
            else { const int a_ = (int)n - 8, bl_ = a_ & 15; u = 64u + (unsigned)(((15 - (15 - (a_ >> 4))) << 7) | ((2 * qg + (bl_ >> 3)) * 8 + (bl_ & 7))); }
        } else {
        if (F.tid == 0) F.MISC[0] = atomicAdd(ctr, 1u);
        __syncthreads();
        u = F.MISC[0];
        __syncthreads();
        }
        if (u >= 64u + 2048u) break;
        if (u < 64u) { if (rep == REP4 - 1 || (PROBE_MASK & 1)) gla::gla_unit((int)u >> 2, (int)u & 3, (const bf16*)(ws + WS_BIG), PLD, PC_GV, PC_GG, (const unsigned char*)out_scratch, (bf16*)(ws + WS_MIX), MLD, SEQ, in[9], F.lds + RING_OFF, (const char*)lds_generic + RING_OFF, (PROBE_HOT && rep != REP4 - 1)); }
        else if (rep == REP4 - 1 || (PROBE_MASK & 2)) { const int a = (int)u - 64; const int bh = a & 127, qb = 15 - (a >> 7);
            sb::sb_unit<SB_EXIT, 1>(bh >> 3, bh & 7, qb, (const bf16*)(ws + WS_BIG), PLD, PC_SQ, PC_SK, PC_SV, (bf16*)(ws + WS_MIX), MLD, 512, SEQ, (char*)lds_generic + RING_OFF, F.lds + RING_OFF); }
    }
}

constexpr int N_PHASES = 9;
#ifndef MK_N_LAUNCHES
#define MK_N_LAUNCHES 1
#endif
struct Args { const float* in[17]; float* out; unsigned char* ws; int ph_lo, ph_hi; };
__global__ void __launch_bounds__(NWAVES * 64, 2) mk_fwd(Args args) {
    extern __shared__ __attribute__((aligned(16))) unsigned char lds[];
    Frame F;
    F.lds = (LAS unsigned char*)lds;
    F.MISC = (volatile LAS unsigned*)(F.lds + MISC_OFF);
    F.tid = threadIdx.x; F.lane = F.tid & 63; F.wave = __builtin_amdgcn_readfirstlane(F.tid >> 6);
    F.G = gridDim.x; { const int bx = blockIdx.x; F.vcu = (F.G % 8 == 0) ? (bx % 8) * (F.G / 8) + bx / 8 : bx; }
    unsigned char* ws = args.ws;
    F.ctl = (gu32*)(ws + WS_CTL);
    for (int u = F.tid; u < (LDS_BYTES - LDSCTL_OFF) / 4; u += NWAVES * 64) ((LAS unsigned*)(F.lds + LDSCTL_OFF))[u] = 0u;
    __syncthreads();
    XcdBarrier bar; bar.bar = (unsigned*)(F.ctl + CW_BAR); bar.x = 0; bar.st = nullptr;
    if (MK_N_LAUNCHES != N_PHASES) bar = xcd_barrier_post((unsigned*)(F.ctl + CW_BAR), F.MISC + 8);
    if (F.tid == 0) __hip_atomic_fetch_or((unsigned*)(F.ctl + CW_GMASK + (blockIdx.x & 7)), 1u << xb_xcc_id(), __ATOMIC_RELAXED, __HIP_MEMORY_SCOPE_AGENT);
    bool lbar = false;
    const int lo = args.ph_lo, hi = args.ph_hi;
#ifndef STAMP_PH
#define STAMP_PH -1
#endif
#ifndef STAMP_K
#define STAMP_K 4
#endif
    unsigned long long st_t0 = 0, st_dt = 0;
#define ST_BEGIN(k) do { if ((k) == STAMP_PH) st_t0 = __builtin_amdgcn_s_memrealtime(); } while (0)
#define ST_END(k) do { if ((k) == STAMP_PH) st_dt = __builtin_amdgcn_s_memrealtime() - st_t0; } while (0)
#define IN(k) (lo <= (k) && (k) < hi)
#define BOTH(k) (IN(k) && IN((k) + 1))
#define GRID_BAR() xcd_barrier(bar)
#ifndef STAGGER_TICKS
#define STAGGER_TICKS 0
#endif
#define STAGGER(ticks) do { if ((ticks) > 0) { const unsigned long long t0_ = __builtin_amdgcn_s_memrealtime(); const unsigned long long d_ = (unsigned long long)(((unsigned)blockIdx.x >> 3) & 7u) * (ticks) / 8; \
        while (__builtin_amdgcn_s_memrealtime() - t0_ < d_) __builtin_amdgcn_s_sleep(4); } } while (0)
#ifndef STAGGER8_TICKS
#define STAGGER8_TICKS 0
#endif
#ifndef STAGGER2_TICKS
#define STAGGER2_TICKS 0
#endif
#ifndef STAGGER6_TICKS
#define STAGGER6_TICKS 0
#endif
#define STAGGER2(ticks) do { if ((ticks) > 0 && (((unsigned)blockIdx.x >> 3) & 1u)) { const unsigned long long t0_ = __builtin_amdgcn_s_memrealtime(); \
        while (__builtin_amdgcn_s_memrealtime() - t0_ < (unsigned long long)(ticks)) __builtin_amdgcn_s_sleep(8); } } while (0)
    bf16* XB = (bf16*)(ws + WS_XB); bf16* MIX = (bf16*)(ws + WS_MIX); bf16* BIG = (bf16*)(ws + WS_BIG);
    float* SS0 = (float*)(ws + WS_SS0); float* SS1 = (float*)(ws + WS_SS1); float* SS2 = (float*)(ws + WS_SS2);
    const float* x = args.in[0]; float* out = args.out;

    ST_BEGIN(0);
    #ifndef W2_LATE
#define W2_LATE 0
#endif
    if (IN(0)) { p0_prologue(F, args.in, ws, W2_LATE ? 1 : 3); if (BOTH(0)) GRID_BAR(); }
    if (MK_N_LAUNCHES == 1) {
        if (F.tid == 0) { unsigned ok = (F.G % 8 == 0) ? 1u : 0u;
            for (int j = 0; j < 8; ++j) { const unsigned mk = __hip_atomic_load((unsigned*)(F.ctl + CW_GMASK + j), __ATOMIC_RELAXED, __HIP_MEMORY_SCOPE_AGENT); if (__builtin_popcount(mk) != 1) ok = 0u; }
            F.MISC[4] = ok; }
        __syncthreads();
        lbar = F.MISC[4] != 0u;
        __syncthreads();
    }
#define SEAM_BAR() do { if (lbar) xcd_barrier_local(bar); else xcd_barrier(bar); } while (0)
#ifndef PROBE1
#define PROBE1 0
#endif
    if (PROBE1 && IN(1)) {
#ifndef PROBE1_K
#define PROBE1_K DM
#endif
#ifndef PROBE1_LD
#define PROBE1_LD PROBE1_K
#endif
        pg8::Gemm g{XB, (const bf16*)(ws + WS_W1), MROWS, 2 * DFF, PROBE1_K, PROBE1_LD, PROBE1_LD};
#ifndef PROBE1_ORDER
#define PROBE1_ORDER pg8::StaticOrder
#endif
        PROBE1_ORDER S; S.init(MROWS, 2 * DFF, F.G, (int)blockIdx.x);
        pg8::EpiSwiGLU<PROBE1> E{BIG, DFF, SS0};
#ifndef PROBE1_ALIGN
#define PROBE1_ALIGN true
#endif
        pg8::gemm_phase<pg8::EpiSwiGLU<PROBE1>, PROBE1_ORDER, PROBE1_ALIGN, true>(F.lds + RING_OFF, g, S, E);
        GRID_BAR();
    }
    ST_END(0);
    ST_BEGIN(1);
    if (IN(1)) {
        pg8::Gemm g{XB, (const bf16*)(ws + WS_W1), MROWS, 2 * DFF, DM, XLD, WLD}; pg8::StaticOrder S; S.init(MROWS, 2 * DFF, F.G, (int)blockIdx.x);
        pg8::EpiSwiGLU<0> E{BIG, ALD, SS0};
        pg8::gemm_phase<pg8::EpiSwiGLU<0>, pg8::StaticOrder, true, true>(F.lds + RING_OFF, g, S, E);
        if (BOTH(1)) SEAM_BAR();
    }
    ST_END(1);
    ST_BEGIN(2);
    if (IN(2)) {
        STAGGER2(STAGGER2_TICKS);
        pg8::Gemm g{BIG, (const bf16*)(ws + WS_WD1), MROWS, DM, DFF, ALD, DFF}; pg8::StaticOrder S; S.init(MROWS, DM, F.G, (int)blockIdx.x);
        pg8::EpiResS E{XB, 0.5f, SS1};
        pg8::gemm_phase<pg8::EpiResS, pg8::StaticOrder, true, true>(F.lds + RING_OFF, g, S, E);
        if (BOTH(2)) SEAM_BAR();
    }
    ST_END(2);
    ST_BEGIN(3);
    if (IN(3)) {
        STAGGER(STAGGER_TICKS);
        pg8::Gemm g{XB, (const bf16*)(ws + WS_WIN), MROWS, NPROJ, DM, XLD, WLD}; pg8::StaticOrder S; S.init(MROWS, NPROJ, F.G, (int)blockIdx.x);
        pg8::EpiProj E{BIG, PLD, SS1, args.in[10], args.in[11], SBQ_SCALE, args.in[9]};
        pg8::gemm_phase<pg8::EpiProj, pg8::StaticOrder, true, true>(F.lds + RING_OFF, g, S, E);
        if (BOTH(3)) SEAM_BAR();
    }
    #ifndef REP4
#define REP4 1
#endif
    ST_END(3);
    ST_BEGIN(4);
    if (IN(4)) {
        { constexpr int NU = BATCH * GLA_H * (SEQ / 256); gla::PrepLoads cur, nxt; int u = (int)blockIdx.x;
          auto unit_of = [&](int s_) { if (!lbar) return s_; const int x_ = s_ & 7, i_ = s_ >> 3; return (((2 * x_ + (i_ >> 6)) * 4 + ((i_ >> 4) & 3)) * 16 + (i_ & 15)); };
          if (u < NU) gla::prep_load(cur, unit_of(u), (const bf16*)(ws + WS_BIG), PLD, PC_GQ, PC_GK, PC_LR, SEQ);
          for (; u < NU; u += F.G) {
              const bool more = (u + F.G < NU);
              if (more) gla::prep_load(nxt, unit_of(u + F.G), (const bf16*)(ws + WS_BIG), PLD, PC_GQ, PC_GK, PC_LR, SEQ);
              gla::prep_unit(cur, unit_of(u), (unsigned char*)args.out, args.in[7], args.in[8], F.lds + RING_OFF);
              if (more) cur = nxt; } }
        if (BOTH(4)) { if (MIX_STEAL_MAX == 0) SEAM_BAR(); else GRID_BAR(); }
    }
    ST_END(4);
    ST_BEGIN(5);
    if (IN(5)) { for (int rep = 0; rep < REP4; ++rep) { p4_mix(F, args.in, ws, args.out, lds, rep, lbar); if (BOTH(5)) { if (MIX_STEAL_MAX == 0) SEAM_BAR(); else GRID_BAR(); } } }
    ST_END(5);
#ifndef PROBE6
#define PROBE6 -1
#endif
    ST_BEGIN(16);
    if (PROBE6 >= 0 && IN(6)) {
        pg8::Gemm g{MIX, (const bf16*)(ws + WS_WOUT), MROWS, DM, DM, MLD, WLD}; pg8::StaticOrder S; S.init(MROWS, DM, F.G, (int)blockIdx.x);
        pg8::EpiResP<(PROBE6 < 0 ? 0 : PROBE6)> E{(PROBE6_PITCH == 1024 ? XB : BIG), BIG, SS0};
        pg8::gemm_phase<pg8::EpiResP<(PROBE6 < 0 ? 0 : PROBE6)>, pg8::StaticOrder, true, true>(F.lds + RING_OFF, g, S, E);
        GRID_BAR();
    }
    ST_END(16);
    ST_BEGIN(6);
    if (IN(6)) {
        STAGGER2(STAGGER6_TICKS);
        pg8::Gemm g{MIX, (const bf16*)(ws + WS_WOUT), MROWS, DM, DM, MLD, WLD}; pg8::StaticOrder S; S.init(MROWS, DM, F.G, (int)blockIdx.x);
        pg8::EpiResS E{XB, 1.0f, SS2};
        pg8::gemm_phase<pg8::EpiResS, pg8::StaticOrder, true, true>(F.lds + RING_OFF, g, S, E);
        if (W2_LATE) p0_prologue(F, args.in, ws, 2);
        if (BOTH(6)) { if (W2_LATE) GRID_BAR(); else SEAM_BAR(); }
    }
    ST_END(6);
    ST_BEGIN(7);
    if (IN(7)) {
        pg8::Gemm g{XB, (const bf16*)(ws + WS_W2), MROWS, 2 * DFF, DM, XLD, WLD}; pg8::StaticOrder S; S.init(MROWS, 2 * DFF, F.G, (int)blockIdx.x);
        pg8::EpiSwiGLU<0> E{BIG, ALD, SS2};
        pg8::gemm_phase<pg8::EpiSwiGLU<0>, pg8::StaticOrder, true, true>(F.lds + RING_OFF, g, S, E);
        if (BOTH(7)) SEAM_BAR();
    }
    ST_END(7);
    ST_BEGIN(8);
    if (IN(8)) {
        STAGGER2(STAGGER8_TICKS);
        pg8::Gemm g{BIG, (const bf16*)(ws + WS_WD2), MROWS, DM, DFF, ALD, DFF}; pg8::StaticOrder S; S.init(MROWS, DM, F.G, (int)blockIdx.x);
        pg8::EpiResOutS E{XB, out, 0.5f};
        pg8::gemm_phase<pg8::EpiResOutS, pg8::StaticOrder, true, true>(F.lds + RING_OFF, g, S, E);
    }
    ST_END(8);
    if (STAMP_PH >= 0 && blockIdx.x == 0 && F.tid == 0) { const unsigned long long te = __builtin_amdgcn_s_memrealtime(); while (__builtin_amdgcn_s_memrealtime() - te < (unsigned long long)STAMP_K * st_dt) __builtin_amdgcn_s_sleep(8); }
#undef IN
#undef BOTH
#undef GRID_BAR
#undef SEAM_BAR
}

extern "C" void kernel_launch(void* const* d_in, const int* in_sizes, int n_in, void* d_out, int out_size, void* d_ws, size_t ws_size, hipStream_t stream) {
    static int grid = 0;
    if (grid == 0) {
        if (n_in != 17 || in_sizes[0] != MROWS * DM || out_size != MROWS * DM || ws_size < WS_END) {
            fprintf(stderr, "kernel_launch: unexpected shapes: n_in %d in0 %d out %d ws %zu (need %zu)\n", n_in, n_in > 0 ? in_sizes[0] : -1, out_size, ws_size, (size_t)WS_END); grid = -1; return; }
        int dev = 0, cus = 0, per_cu = 0;
        if (hipGetDevice(&dev) != hipSuccess || hipDeviceGetAttribute(&cus, hipDeviceAttributeMultiprocessorCount, dev) != hipSuccess) { grid = -1; return; }
        if (hipFuncSetAttribute((const void*)mk_fwd, hipFuncAttributeMaxDynamicSharedMemorySize, LDS_BYTES) != hipSuccess) { fprintf(stderr, "kernel_launch: hipFuncSetAttribute failed\n"); grid = -1; return; }
        if (hipOccupancyMaxActiveBlocksPerMultiprocessor(&per_cu, (const void*)mk_fwd, NWAVES * 64, LDS_BYTES) != hipSuccess || per_cu < 1)
            fprintf(stderr, "kernel_launch: occupancy query reports %d workgroups per CU\n", per_cu);
        (void)hipGetLastError();
        grid = cus;
    }
    if (grid < 0) return;
    if (hipMemsetAsync((char*)d_ws + WS_CTL, 0, CTL_ZERO_BYTES, stream) != hipSuccess) { fprintf(stderr, "kernel_launch: memset failed\n"); return; }
    Args a{};
    for (int i = 0; i < 17; ++i) a.in[i] = (const float*)d_in[i];
    a.out = (float*)d_out; a.ws = (unsigned char*)d_ws;
    for (int li = 0; li < MK_N_LAUNCHES; ++li) {
        if (MK_N_LAUNCHES == N_PHASES) { a.ph_lo = li; a.ph_hi = li + 1; } else { a.ph_lo = 0; a.ph_hi = N_PHASES; }
        hipLaunchKernelGGL(mk_fwd, dim3(grid), dim3(NWAVES * 64), LDS_BYTES, stream, a);
        const hipError_t le = hipPeekAtLastError();
        if (le != hipSuccess) { fprintf(stderr, "kernel_launch: launch %d failed: %s\n", li, hipGetErrorName(le)); break; }
    }
}
```
